# Optimizing an MI355X kernel written in HIP

```python
import jax, jax.numpy as jnp
from jax import lax
import numpy as np

D_MODEL = 1024
BATCH = 4
SEQ = 4096
DEPTH = 1

MEM_LEN = 256
EPS = 1e-6
CONV_WIDTH = 3
A_WIDTH = D_MODEL // 2
HEAD_DIM = 64
ATTN_WIDTH = D_MODEL // 2
N_Q_HEADS = ATTN_WIDTH // HEAD_DIM
N_KV_HEADS = N_Q_HEADS // 4
KV_WIDTH = N_KV_HEADS * HEAD_DIM
WINDOW = 128
BLOCK = 128
ROPE_THETA = 500000.0
ROT_DIM = HEAD_DIM // 4
MEM_HEADS = 4
MEM_HEAD_DIM = D_MODEL // 8
MEM_WIDTH = MEM_HEADS * MEM_HEAD_DIM
N_BRANCHES = 3
IN_SIZES = (A_WIDTH, A_WIDTH, A_WIDTH, A_WIDTH,
            ATTN_WIDTH, KV_WIDTH, KV_WIDTH, ATTN_WIDTH,
            MEM_WIDTH, MEM_WIDTH,
            N_BRANCHES * D_MODEL)
IN_WIDTH = sum(IN_SIZES)

kernel_name = "hybrid_gated_conv_swa_memxattn_block"


def rms_norm(x, g):
    xf = x.astype(jnp.float32)
    y = xf * lax.rsqrt(jnp.mean(xf * xf, axis=-1, keepdims=True) + EPS)
    return (y * g.astype(jnp.float32)).astype(x.dtype)


def partial_rope(t, pos):
    half = ROT_DIM // 2
    inv_freq = jnp.power(jnp.float32(ROPE_THETA), -jnp.arange(half, dtype=jnp.float32) * (2.0 / ROT_DIM))
    ang = pos.astype(jnp.float32)[:, None] * inv_freq[None, :]
    cos = jnp.cos(ang)[None, :, None, :]
    sin = jnp.sin(ang)[None, :, None, :]
    tr = t[..., :ROT_DIM].astype(jnp.float32)
    t1, t2 = tr[..., :half], tr[..., half:]
    rot = jnp.concatenate([t1 * cos - t2 * sin, t2 * cos + t1 * sin], axis=-1).astype(t.dtype)
    return jnp.concatenate([rot, t[..., ROT_DIM:]], axis=-1)


def short_gated_conv(b, c, u, w_conv):
    s = u.shape[1]
    cu = jnp.pad(c * u, ((0, 0), (1, 1), (0, 0)))
    y = cu[:, :s] * w_conv[0] + cu[:, 1:s + 1] * w_conv[1] + cu[:, 2:] * w_conv[2]
    return b * y


def window_attention_with_sink(q, k, v, sink):
    bsz, s, hq, dh = q.shape
    hkv = k.shape[2]
    grp = hq // hkv
    nb = s // BLOCK
    qb = q.reshape(bsz, nb, BLOCK, hkv, grp, dh)
    pad = ((0, 0), (BLOCK, BLOCK), (0, 0), (0, 0))
    kp = jnp.pad(k, pad).reshape(bsz, nb + 2, BLOCK, hkv, dh)
    vp = jnp.pad(v, pad).reshape(bsz, nb + 2, BLOCK, hkv, dh)
    kw = jnp.concatenate([kp[:, :nb], kp[:, 1:nb + 1], kp[:, 2:]], axis=2)
    vw = jnp.concatenate([vp[:, :nb], vp[:, 1:nb + 1], vp[:, 2:]], axis=2)
    qpos = jnp.arange(nb)[:, None] * BLOCK + jnp.arange(BLOCK)[None, :]
    kpos = (jnp.arange(nb)[:, None] - 1) * BLOCK + jnp.arange(3 * BLOCK)[None, :]
    valid = ((jnp.abs(qpos[:, :, None] - kpos[:, None, :]) <= WINDOW)
             & (kpos >= 0)[:, None, :] & (kpos < s)[:, None, :])
    scores = jnp.einsum('bnqhgd,bnkhd->bnhgqk', qb, kw,
                        preferred_element_type=jnp.float32) * (dh ** -0.5)
    scores = jnp.where(valid[None, :, None, None], scores, -jnp.inf)
    sink_l = sink.astype(jnp.float32).reshape(hkv, grp)[None, None, :, :, None, None]
    m = jnp.maximum(jnp.max(scores, axis=-1, keepdims=True), sink_l)
    p = jnp.exp(scores - m)
    p = p / (jnp.sum(p, axis=-1, keepdims=True) + jnp.exp(sink_l - m))
    out = jnp.einsum('bnhgqk,bnkhd->bnqhgd', p.astype(v.dtype), vw)
    return out.reshape(bsz, s, hq * dh)


def memory_cross_attention(q, mk, mv):
    dm = q.shape[-1]
    scores = jnp.einsum('bshd,bmhd->bhsm', q, mk,
                        preferred_element_type=jnp.float32) * (dm ** -0.5)
    p = jax.nn.softmax(scores, axis=-1)
    out = jnp.einsum('bhsm,bmhd->bshd', p.astype(mv.dtype), mv)
    return out.reshape(q.shape[0], q.shape[1], -1)


def hybrid_layer(x, mem, g_pre, w_in, w_conv, attn_sink, g_mem, w_mem_kv,
                 w_up_a, w_up_b, w_up_m, w_out, g_post):
    bsz, s, d = x.shape
    h = rms_norm(x, g_pre)
    proj = h @ w_in
    idx = list(np.cumsum(IN_SIZES)[:-1])
    (a_b, a_c, a_x, a_z, b_q, b_k, b_v, b_z, m_q, m_z, gate_logits) = jnp.split(proj, idx, axis=-1)

    ya = short_gated_conv(a_b, a_c, a_x, w_conv) * jax.nn.silu(a_z)
    ua = ya @ w_up_a

    pos = jnp.arange(s)
    q = partial_rope(b_q.reshape(bsz, s, N_Q_HEADS, HEAD_DIM), pos)
    k = partial_rope(b_k.reshape(bsz, s, N_KV_HEADS, HEAD_DIM), pos)
    v = b_v.reshape(bsz, s, N_KV_HEADS, HEAD_DIM)
    yb = window_attention_with_sink(q, k, v, attn_sink) * jax.nn.silu(b_z)
    ub = yb @ w_up_b

    mn = rms_norm(mem, g_mem)
    mkv = mn @ w_mem_kv
    mk, mv = jnp.split(mkv, 2, axis=-1)
    mlen = mem.shape[1]
    ym = memory_cross_attention(m_q.reshape(bsz, s, MEM_HEADS, MEM_HEAD_DIM),
                                mk.reshape(bsz, mlen, MEM_HEADS, MEM_HEAD_DIM),
                                mv.reshape(bsz, mlen, MEM_HEADS, MEM_HEAD_DIM)) * jax.nn.silu(m_z)
    um = ym @ w_up_m

    gates = jax.nn.sigmoid(gate_logits.astype(jnp.float32)).astype(x.dtype).reshape(bsz, s, N_BRANCHES, d)
    merged = gates[:, :, 0] * ua + gates[:, :, 1] * ub + gates[:, :, 2] * um
    out = merged @ w_out
    return x + rms_norm(out, g_post)


def setup_inputs(seed: int = 0) -> dict:
    key = jax.random.key(seed)
    ks = jax.random.split(key, 14)
    f32 = jnp.float32
    nrm = lambda k, shape, fan_in: jax.random.normal(k, shape, f32) * (fan_in ** -0.5)
    gain = lambda k, shape: 1.0 + 0.05 * jax.random.normal(k, shape, f32)
    return {
        "x": jax.random.normal(ks[0], (BATCH, SEQ, D_MODEL), f32),
        "mem": jax.random.normal(ks[1], (BATCH, MEM_LEN, D_MODEL), f32),
        "g_pre": gain(ks[2], (DEPTH, D_MODEL)),
        "w_in": nrm(ks[3], (DEPTH, D_MODEL, IN_WIDTH), D_MODEL),
        "w_conv": nrm(ks[4], (DEPTH, CONV_WIDTH, A_WIDTH), CONV_WIDTH),
        "attn_sink": 0.5 * jax.random.normal(ks[5], (DEPTH, N_Q_HEADS), f32),
        "g_mem": gain(ks[6], (DEPTH, D_MODEL)),
        "w_mem_kv": nrm(ks[7], (DEPTH, D_MODEL, 2 * MEM_WIDTH), D_MODEL),
        "w_up_a": nrm(ks[8], (DEPTH, A_WIDTH, D_MODEL), A_WIDTH),
        "w_up_b": nrm(ks[9], (DEPTH, ATTN_WIDTH, D_MODEL), ATTN_WIDTH),
        "w_up_m": nrm(ks[10], (DEPTH, MEM_WIDTH, D_MODEL), MEM_WIDTH),
        "w_out": nrm(ks[11], (DEPTH, D_MODEL, D_MODEL), D_MODEL),
        "g_post": gain(ks[12], (DEPTH, D_MODEL)),
    }


def reference(x, mem, g_pre, w_in, w_conv, attn_sink, g_mem, w_mem_kv,
              w_up_a, w_up_b, w_up_m, w_out, g_post):
    for l in range(DEPTH):
        x = hybrid_layer(x, mem, g_pre[l], w_in[l], w_conv[l], attn_sink[l], g_mem[l],
                         w_mem_kv[l], w_up_a[l], w_up_b[l], w_up_m[l], w_out[l], g_post[l])
    return x
```

```cpp
#include <hip/hip_runtime.h>
#include <hip/hip_cooperative_groups.h>
#include <cstdio>
#include <cstdint>
namespace cg = cooperative_groups;

#ifndef PH_SKIP_MASK
#define PH_SKIP_MASK 0
#endif

#define LAS __attribute__((address_space(3)))
typedef unsigned short bf16_t;
typedef short bf16x8 __attribute__((ext_vector_type(8)));
typedef float f32x4 __attribute__((ext_vector_type(4)));
typedef float f32x2 __attribute__((ext_vector_type(2)));
typedef unsigned u32x4 __attribute__((ext_vector_type(4)));
typedef unsigned u32x2 __attribute__((ext_vector_type(2)));

constexpr int NB = 4, SEQ = 4096, D = 1024, M = NB * SEQ;
constexpr int MEML = 256, MROWS = NB * MEML;
constexpr int PA_W = 4352, GT_W = 3072, IN_W = PA_W + GT_W;
constexpr int C_AB = 0, C_AC = 512, C_AX = 1024, C_AZ = 1536, C_BQ = 2048, C_BK = 2560, C_BV = 2688, C_BZ = 2816, C_MQ = 3328, C_MZ = 3840;
constexpr int Y_W = 1536;
constexpr float EPS = 1e-6f;

constexpr size_t WS_CTL = 0;
constexpr size_t WS_WIN = 65536;
constexpr size_t WS_WMKV = WS_WIN + (size_t)IN_W * D * 2;
constexpr size_t WS_WUP = WS_WMKV + (size_t)D * D * 2;
constexpr size_t WS_WOUT = WS_WUP + (size_t)D * Y_W * 2;
constexpr size_t WS_ROPE = WS_WOUT + (size_t)D * D * 2;
constexpr size_t WS_MKV = WS_ROPE + (size_t)SEQ * 16 * 4;
constexpr size_t WS_PROJA = 25165824;
constexpr size_t WS_GATES = WS_PROJA + (size_t)M * PA_W * 2;
constexpr size_t WS_END = WS_GATES + (size_t)M * GT_W * 2;
static_assert(WS_MKV + (size_t)MROWS * D * 2 <= WS_PROJA && WS_END == 268435456, "d_ws map");
constexpr size_t WS_CNT = 16384;
constexpr size_t WS_XBUF = WS_ROPE;
constexpr size_t WS_OUTPRE = WS_GATES;
constexpr size_t DO_H = 0, DO_MN = (size_t)M * D * 2, DO_Y = 0;

constexpr int LDS_BYTES = 143360;
constexpr int NWAVES = 8;
constexpr int MISC_OFF = LDS_BYTES - 64;
constexpr size_t CTL_ZERO_BYTES = 32768;

__device__ __forceinline__ unsigned cvt_pk_bf16(float lo, float hi) { unsigned r; asm volatile("v_cvt_pk_bf16_f32 %0, %1, %2" : "=v"(r) : "v"(lo), "v"(hi)); return r; }
__device__ __forceinline__ float bf_lo(unsigned w) { return __uint_as_float(w << 16); }
__device__ __forceinline__ float bf_hi(unsigned w) { return __uint_as_float(w & 0xffff0000u); }
__device__ __forceinline__ float silu_f(float z) { return z * __builtin_amdgcn_rcpf(1.0f + __expf(-z)); }
__device__ __forceinline__ bf16x8 pack8(f32x4 a, f32x4 b) { u32x4 w; w.x = cvt_pk_bf16(a[0], a[1]); w.y = cvt_pk_bf16(a[2], a[3]); w.z = cvt_pk_bf16(b[0], b[1]); w.w = cvt_pk_bf16(b[2], b[3]); return __builtin_bit_cast(bf16x8, w); }
__device__ __forceinline__ float wave_sum(float v) {
#pragma unroll
    for (int o = 1; o < 64; o <<= 1) v += __shfl_xor(v, o);
    return v;
}
#define LDS_WAIT() asm volatile("s_waitcnt lgkmcnt(0)" ::: "memory")
__device__ __forceinline__ float xmax16(float v) { auto r = __builtin_amdgcn_permlane16_swap(__float_as_uint(v), __float_as_uint(v), false, false); return fmaxf(__uint_as_float(r[0]), __uint_as_float(r[1])); }
__device__ __forceinline__ float xmax32(float v) { auto r = __builtin_amdgcn_permlane32_swap(__float_as_uint(v), __float_as_uint(v), false, false); return fmaxf(__uint_as_float(r[0]), __uint_as_float(r[1])); }
__device__ __forceinline__ float xsum16(float v) { auto r = __builtin_amdgcn_permlane16_swap(__float_as_uint(v), __float_as_uint(v), false, false); return __uint_as_float(r[0]) + __uint_as_float(r[1]); }
__device__ __forceinline__ float xsum32(float v) { auto r = __builtin_amdgcn_permlane32_swap(__float_as_uint(v), __float_as_uint(v), false, false); return __uint_as_float(r[0]) + __uint_as_float(r[1]); }

namespace pg8 {
constexpr int BM = 256, BK = 64, HALF = 128, HTB = HALF * BK * 2, STAGE_BYTES = 8 * HTB, NXCD = 8, WGM = 8;
__host__ __device__ __forceinline__ int lds_byte(int r, int c) { const int st = (r >> 4) * 2 + (c >> 5), rr = r & 15, cc = c & 31, ob = rr * 64 + cc * 2; return st * 1024 + (ob ^ (((ob >> 9) & 1) << 5)); }
__host__ __device__ __forceinline__ void stage_rc(int b, int& R, int& C) { const int st = b / 1024, sb = b % 1024, swz = sb ^ (((sb >> 9) & 1) << 5); R = (st >> 1) * 16 + swz / 64; C = (st & 1) * 32 + (swz % 64) / 2; }
__host__ __device__ __forceinline__ int perm32(int rho) { const int n = rho >> 4, i = rho & 15; return 8 * (i >> 2) + 4 * n + (i & 3); }

struct Unit { int pm, pn, half; };
struct Gemm { const bf16_t* A; const bf16_t* Bt; int M, N, K; int lda; int j1, j2; };

struct StaticOrder {
    int nM, nN, nwg, G, c;
    __device__ void init(int M_, int N_, int G_, int c_) { nM = M_ / BM; nN = N_ / BM; nwg = nM * nN; G = G_; c = c_; }
    __device__ bool next(int i, Unit& u) const {
        const long L = (long)i * G + c; if (L >= nwg) return false;
        int wgid = (int)L; { const int q = nwg / NXCD, r = nwg % NXCD, xcd = wgid % NXCD, off = wgid / NXCD; wgid = (xcd < r ? xcd * (q + 1) : r * (q + 1) + (xcd - r) * q) + off; }
        const int nig = WGM * nN, gid = wgid / nig, fm = gid * WGM, gsz = (nM - fm) < WGM ? (nM - fm) : WGM;
        u.pm = fm + ((wgid % nig) % gsz); u.pn = (wgid % nig) / gsz; u.half = 0; return true;
    }
};
constexpr int PROJ_FULL = 1792, PROJ_TOTAL = PROJ_FULL + 160;
struct ProjOrder {
    int G, c;
    __device__ bool next(int i, Unit& u) const {
        const int L = i * G + c; if (L >= PROJ_TOTAL) return false;
        const int F = L - 160, o = F >> 3, e = L, uid = e >> 1, m = uid - 64;
        const bool full = L >= 160, t28 = uid < 64;
        const int pm = full ? (F & 7) * 8 + (o & 7) : (t28 ? uid : 64 + (m >> 2));
        const int pn = full ? 27 - (o >> 3) : (t28 ? 28 : 29 + (m & 3));
        const int half = full ? 0 : 1 + (e & 1);
        u.pm = pm; u.pn = pn; u.half = half; return true;
    }
};

struct EpiProj {
    static constexpr bool PERM = true, SEGMENTED = false, AFTER_DRAIN = false;
    bf16_t* projA; bf16_t* gates; bf16_t* mkv;
    __device__ __forceinline__ void rescale(f32x4 (&)[2][2][4][2], const Unit&, int, int, int, int, int) const {}
    __device__ __forceinline__ void operator()(f32x4 (&acc)[2][2][4][2], const Unit& u, int wr, int wc, int fr, int fq) const {
        bf16_t* base; int ldc, colt, rowt = u.pm * BM;
        if (u.pn < 17) { base = projA; ldc = PA_W; colt = u.pn * BM; }
        else if (u.pn < 29) { base = gates; ldc = GT_W; colt = (u.pn - 17) * BM; }
        else { base = mkv; ldc = D; colt = (u.pn - 29) * BM; rowt -= M; }
        const int row0 = rowt + (u.half == 2 ? HALF : 0) + wr * 64 + fr, col0 = colt + wc * 32 + 8 * fq;
        const bool is_gate = (u.pn >= 17) && (u.pn < 29);
#pragma unroll
        for (int ai = 0; ai < 2; ++ai) {
            if (ai == 1 && u.half) break;
#pragma unroll
            for (int m = 0; m < 4; ++m) { bf16_t* rowp = base + (size_t)(row0 + ai * HALF + m * 16) * ldc + col0;
#pragma unroll
                for (int bj = 0; bj < 2; ++bj) { f32x4 v0 = acc[ai][bj][m][0], v1 = acc[ai][bj][m][1];
                    if (is_gate) {
#pragma unroll
                        for (int e = 0; e < 4; ++e) { v0[e] = 1.0f + __builtin_amdgcn_exp2f(__builtin_amdgcn_fmed3f(v0[e], -60.f, 60.f) * -1.4426950408889634f);
                            v1[e] = 1.0f + __builtin_amdgcn_exp2f(__builtin_amdgcn_fmed3f(v1[e], -60.f, 60.f) * -1.4426950408889634f); } }
                    u32x4 w; w.x = cvt_pk_bf16(v0[0], v0[1]); w.y = cvt_pk_bf16(v0[2], v0[3]); w.z = cvt_pk_bf16(v1[0], v1[1]); w.w = cvt_pk_bf16(v1[2], v1[3]);
                    *(u32x4*)(rowp + bj * HALF) = w; } }
        }
    }
};
struct EpiPlain {
    static constexpr bool PERM = true, SEGMENTED = false, AFTER_DRAIN = false;
    bf16_t* O; int ldc;
    __device__ __forceinline__ void rescale(f32x4 (&)[2][2][4][2], const Unit&, int, int, int, int, int) const {}
    __device__ __forceinline__ void operator()(f32x4 (&acc)[2][2][4][2], const Unit& u, int wr, int wc, int fr, int fq) const {
        const int row0 = u.pm * BM + wr * 64 + fr, col0 = u.pn * BM + wc * 32 + 8 * fq;
#pragma unroll
        for (int ai = 0; ai < 2; ++ai)
#pragma unroll
            for (int m = 0; m < 4; ++m) { bf16_t* rowp = O + (size_t)(row0 + ai * HALF + m * 16) * ldc + col0;
#pragma unroll
                for (int bj = 0; bj < 2; ++bj) { const f32x4 v0 = acc[ai][bj][m][0], v1 = acc[ai][bj][m][1];
                    u32x4 w; w.x = cvt_pk_bf16(v0[0], v0[1]); w.y = cvt_pk_bf16(v0[2], v0[3]); w.z = cvt_pk_bf16(v1[0], v1[1]); w.w = cvt_pk_bf16(v1[2], v1[3]);
                    *(u32x4*)(rowp + bj * HALF) = w; } }
    }
};
struct EpiMerge {
    static constexpr bool PERM = true, SEGMENTED = true, AFTER_DRAIN = false;
    const bf16_t* gates; bf16_t* O; int ldc;
    static __device__ __forceinline__ float e_neg(float l) { l = fminf(fmaxf(l, -60.f), 60.f); return __expf(-l); }
    __device__ __forceinline__ void rescale(f32x4 (&acc)[2][2][4][2], const Unit& u, int wr, int wc, int fr, int fq, int seg) const {
        const int row0 = u.pm * BM + wr * 64 + fr, col0 = u.pn * BM + wc * 32 + 8 * fq;
        const bf16_t* gp0 = gates + (size_t)row0 * GT_W + col0 + seg * D;
        asm volatile("" : "+v"(gp0));
#pragma unroll
        for (int ai = 0; ai < 2; ++ai)
#pragma unroll
            for (int m = 0; m < 4; ++m) { const bf16_t* gp = gp0 + (size_t)(ai * HALF + m * 16) * GT_W;
#pragma unroll
                for (int bj = 0; bj < 2; ++bj) { const u32x4 la = *(const u32x4*)(gp + bj * HALF), lb = *(const u32x4*)(gp + bj * HALF + D);
#pragma unroll
                    for (int e = 0; e < 4; ++e) { const float r0 = bf_lo(lb[e]) * __builtin_amdgcn_rcpf(bf_lo(la[e]));
                        const float r1 = bf_hi(lb[e]) * __builtin_amdgcn_rcpf(bf_hi(la[e]));
                        acc[ai][bj][m][e >> 1][(e & 1) * 2] *= r0; acc[ai][bj][m][e >> 1][(e & 1) * 2 + 1] *= r1; } }
                if (m == 3) asm volatile("" ::: "memory"); }
    }
    __device__ __forceinline__ void operator()(f32x4 (&acc)[2][2][4][2], const Unit& u, int wr, int wc, int fr, int fq) const {
        const int row0 = u.pm * BM + wr * 64 + fr, col0 = u.pn * BM + wc * 32 + 8 * fq;
        u32x4 lg[2][4][2];
#pragma unroll
        for (int ai = 0; ai < 2; ++ai)
#pragma unroll
            for (int m = 0; m < 4; ++m)
#pragma unroll
                for (int bj = 0; bj < 2; ++bj) lg[ai][m][bj] = *(const u32x4*)(gates + (size_t)(row0 + ai * HALF + m * 16) * GT_W + col0 + 2 * D + bj * HALF);
#pragma unroll
        for (int ai = 0; ai < 2; ++ai)
#pragma unroll
            for (int m = 0; m < 4; ++m) { const size_t r = (size_t)(row0 + ai * HALF + m * 16); bf16_t* rowp = O + r * ldc + col0;
#pragma unroll
                for (int bj = 0; bj < 2; ++bj) { const u32x4 la = lg[ai][m][bj]; float v[8];
#pragma unroll
                    for (int e = 0; e < 4; ++e) { v[2 * e] = acc[ai][bj][m][e >> 1][(e & 1) * 2] * __builtin_amdgcn_rcpf(bf_lo(la[e]));
                        v[2 * e + 1] = acc[ai][bj][m][e >> 1][(e & 1) * 2 + 1] * __builtin_amdgcn_rcpf(bf_hi(la[e])); }
                    u32x4 w; w.x = cvt_pk_bf16(v[0], v[1]); w.y = cvt_pk_bf16(v[2], v[3]); w.z = cvt_pk_bf16(v[4], v[5]); w.w = cvt_pk_bf16(v[6], v[7]);
                    *(u32x4*)(rowp + bj * HALF) = w; } }
    }
};

struct EpiRmsRes {
    static constexpr bool PERM = true, SEGMENTED = false, AFTER_DRAIN = true;
    const float* x; const float* g; float* out; float* xbuf; unsigned* cnt;
    __device__ __forceinline__ void rescale(f32x4 (&)[2][2][4][2], const Unit&, int, int, int, int, int) const {}
    __device__ __forceinline__ void operator()(f32x4 (&)[2][2][4][2], const Unit&, int, int, int, int) const {}
    __device__ __forceinline__ void fused(f32x4 (&acc)[2][2][4][2], const Unit& u, int wr, int wc, int fr, int fq, LAS unsigned char* lds, int wid, int lane) const {
        LAS float* P = (LAS float*)lds;
        LAS float* S = (LAS float*)(lds + 4096);
        const int tid = wid * 64 + lane;
        const int col0 = u.pn * BM + wc * 32 + 8 * fq;
        f32x4 pre[4][2][2];
#pragma unroll
        for (int m = 0; m < 4; ++m) { const size_t off = (size_t)(u.pm * BM + wr * 64 + m * 16 + fr) * D + col0;
#pragma unroll
            for (int bj = 0; bj < 2; ++bj)
#pragma unroll
                for (int n = 0; n < 2; ++n) pre[m][bj][n] = *(const f32x4*)(x + off + bj * HALF + 4 * n); }
#pragma unroll
        for (int ai = 0; ai < 2; ++ai)
#pragma unroll
            for (int m = 0; m < 4; ++m) { float q = 0.f;
#pragma unroll
                for (int bj = 0; bj < 2; ++bj)
#pragma unroll
                    for (int n = 0; n < 2; ++n) { const f32x4 v = acc[ai][bj][m][n]; q += (v[0] * v[0] + v[1] * v[1]) + (v[2] * v[2] + v[3] * v[3]); }
                q += __shfl_xor(q, 16); q += __shfl_xor(q, 32);
                if (fq == 0) P[(ai * HALF + wr * 64 + m * 16 + fr) * 4 + wc] = q; }
        asm volatile("s_waitcnt lgkmcnt(0)" ::: "memory"); __builtin_amdgcn_s_barrier(); asm volatile("" ::: "memory");
        if (tid < 256) { const float t = (P[tid * 4] + P[tid * 4 + 1]) + (P[tid * 4 + 2] + P[tid * 4 + 3]);
            __hip_atomic_store(xbuf + ((u.pm * 4 + u.pn) * 256 + tid), t, __ATOMIC_RELAXED, __HIP_MEMORY_SCOPE_AGENT); }
        asm volatile("s_waitcnt vmcnt(0)" ::: "memory");
        if (lane == 0) __hip_atomic_fetch_add(cnt + 64 * u.pm, 1u, __ATOMIC_RELAXED, __HIP_MEMORY_SCOPE_AGENT);
        if (wid == 0) {
            unsigned sp = 0;
            while ((unsigned)__builtin_amdgcn_readfirstlane(__hip_atomic_load(cnt + 64 * u.pm, __ATOMIC_RELAXED, __HIP_MEMORY_SCOPE_AGENT)) < 32u) { __builtin_amdgcn_s_sleep(2); if (++sp > (1u << 20)) break; }
            __builtin_amdgcn_fence(__ATOMIC_ACQUIRE, "agent");
        }
        asm volatile("s_waitcnt vmcnt(0) lgkmcnt(0)" ::: "memory"); __builtin_amdgcn_s_barrier(); asm volatile("" ::: "memory");
        if (tid < 256) { float t = 0.f;
#pragma unroll
            for (int pn = 0; pn < 4; ++pn) t += __hip_atomic_load(xbuf + ((u.pm * 4 + pn) * 256 + tid), __ATOMIC_RELAXED, __HIP_MEMORY_SCOPE_AGENT);
            S[tid] = 1.0f / sqrtf(t * (1.0f / D) + EPS); }
        asm volatile("s_waitcnt lgkmcnt(0)" ::: "memory"); __builtin_amdgcn_s_barrier(); asm volatile("" ::: "memory");
        f32x4 gv[2][2];
#pragma unroll
        for (int bj = 0; bj < 2; ++bj)
#pragma unroll
            for (int n = 0; n < 2; ++n) gv[bj][n] = *(const f32x4*)(g + col0 + bj * HALF + 4 * n);
#pragma unroll
        for (int m = 0; m < 4; ++m) { const int r = wr * 64 + m * 16 + fr; const float rs = S[r]; const size_t off = (size_t)(u.pm * BM + r) * D + col0;
#pragma unroll
            for (int bj = 0; bj < 2; ++bj)
#pragma unroll
                for (int n = 0; n < 2; ++n) *(f32x4*)(out + off + bj * HALF + 4 * n) = pre[m][bj][n] + acc[0][bj][m][n] * rs * gv[bj][n]; }
        asm volatile("" ::: "memory");
#pragma unroll
        for (int m = 0; m < 4; ++m) { const size_t off = (size_t)(u.pm * BM + HALF + wr * 64 + m * 16 + fr) * D + col0;
#pragma unroll
            for (int bj = 0; bj < 2; ++bj)
#pragma unroll
                for (int n = 0; n < 2; ++n) pre[m][bj][n] = *(const f32x4*)(x + off + bj * HALF + 4 * n); }
#pragma unroll
        for (int m = 0; m < 4; ++m) { const int r = HALF + wr * 64 + m * 16 + fr; const float rs = S[r]; const size_t off = (size_t)(u.pm * BM + r) * D + col0;
#pragma unroll
            for (int bj = 0; bj < 2; ++bj)
#pragma unroll
                for (int n = 0; n < 2; ++n) *(f32x4*)(out + off + bj * HALF + 4 * n) = pre[m][bj][n] + acc[1][bj][m][n] * rs * gv[bj][n]; }
    }
};

template <class Epi, class Sched, bool ALIGN_EPI = true>
__device__ __forceinline__ void gemm_phase(LAS unsigned char* lds, const Gemm g, const Sched& S, const Epi& E) {
    const int tid = threadIdx.x, wid = __builtin_amdgcn_readfirstlane(tid >> 6), lane = tid & 63, wr = wid >> 2, wc = wid & 3, fr = lane & 15, fq = lane >> 4;
    const int K = g.K, nt = K / BK;
    unsigned voffA[2], voffB[2];
#pragma unroll
    for (int i = 0; i < 2; ++i) { int R, C; stage_rc(tid * 16 + i * 8192, R, C); const int Rb = Epi::PERM ? ((R & ~31) + perm32(R & 31)) : R;
        voffA[i] = (unsigned)(R * g.lda + C) * 2u; voffB[i] = (unsigned)(Rb * K + C) * 2u; }
    const size_t kstep = (size_t)(BK * 2);
    const size_t hstep = (size_t)HALF * K * 2, tstep = 2 * hstep;
    const size_t hstepA = (size_t)HALF * g.lda * 2, tstepA = 2 * hstepA;
#define PG8_AJ(t) (Epi::SEGMENTED ? (size_t)(((t) >= 8 ? g.j1 : 0) + ((t) >= 16 ? g.j2 : 0)) : (size_t)0)
    const unsigned ldsw = (unsigned)wid * 1024u;
    const int aoff = lds_byte(wr * 64 + fr, fq * 8), boff = lds_byte(wc * 32 + fr, fq * 8);
#define PG8_SA(b, h) (((b) * 2 + (h)) * HTB)
#define PG8_SB(b, h) ((4 + (b) * 2 + (h)) * HTB)
#define PG8_STAGE(bufoff, gbase, voff) do { _Pragma("unroll") for (int _i = 0; _i < 2; ++_i) \
        __builtin_amdgcn_global_load_lds((const unsigned*)((const char*)(gbase) + (voff)[_i]), (LAS unsigned*)(lds + (bufoff) + ldsw + _i * 8192), 16, 0, 0); } while (0)
#define PG8_LDA(dst, b, h) do { _Pragma("unroll") for (int m = 0; m < 4; ++m) _Pragma("unroll") for (int k = 0; k < 2; ++k) dst[m][k] = *(const LAS bf16x8*)(lds + PG8_SA(b, h) + aoff + m * 2048 + k * 1024); } while (0)
#define PG8_LDB(dst, b, h) do { _Pragma("unroll") for (int n = 0; n < 2; ++n) _Pragma("unroll") for (int k = 0; k < 2; ++k) dst[n][k] = *(const LAS bf16x8*)(lds + PG8_SB(b, h) + boff + n * 2048 + k * 1024); } while (0)
#define PG8_MMA(ai, bj, At, Bt) do { __builtin_amdgcn_s_setprio(1); _Pragma("unroll") for (int m = 0; m < 4; ++m) _Pragma("unroll") for (int n = 0; n < 2; ++n) _Pragma("unroll") for (int k = 0; k < 2; ++k) \
        acc[ai][bj][m][n] = __builtin_amdgcn_mfma_f32_16x16x32_bf16(Bt[n][k], At[m][k], acc[ai][bj][m][n], 0, 0, 0); __builtin_amdgcn_s_setprio(0); } while (0)
#define PG8_WAIT_V(n) asm volatile("s_waitcnt vmcnt(" #n ")" ::: "memory")
#define PG8_WAIT_L(n) asm volatile("s_waitcnt lgkmcnt(" #n ")" ::: "memory")
#define PG8_BAR __builtin_amdgcn_s_barrier()
#define PG8_SCHED __builtin_amdgcn_sched_barrier(0)
    Unit cur, nxt; int ui = 0;
    if (!S.next(0, cur)) return;
    f32x4 acc[2][2][4][2];
#pragma unroll
    for (int a = 0; a < 2; ++a)
#pragma unroll
        for (int b = 0; b < 2; ++b)
#pragma unroll
            for (int m = 0; m < 4; ++m)
#pragma unroll
                for (int n = 0; n < 2; ++n) acc[a][b][m][n] = (f32x4){0.f, 0.f, 0.f, 0.f};
    bf16x8 At[4][2], B0[2][2], B1[2][2];
    const char* cA = (const char*)g.A + (size_t)cur.pm * tstepA + (cur.half == 2 ? hstepA : 0); const char* cB = (const char*)g.Bt + (size_t)cur.pn * tstep;
    PG8_STAGE(PG8_SB(0, 0), cB, voffB); PG8_STAGE(PG8_SB(0, 1), cB + hstep, voffB); PG8_STAGE(PG8_SA(0, 0), cA, voffA); PG8_STAGE(PG8_SA(0, 1), cA + hstepA, voffA);
    if (wr == 1) PG8_BAR;
    PG8_WAIT_V(2); PG8_BAR;
    PG8_STAGE(PG8_SB(1, 0), cB + kstep, voffB); PG8_STAGE(PG8_SA(1, 0), cA + kstep, voffA); PG8_STAGE(PG8_SB(1, 1), cB + hstep + kstep, voffB);
    PG8_WAIT_V(6); PG8_BAR;
    for (;;) {
        const bool has_next = S.next(ui + 1, nxt);
        const char* nA = has_next ? (const char*)g.A + (size_t)nxt.pm * tstepA + (nxt.half == 2 ? hstepA : 0) : cA; const char* nB = has_next ? (const char*)g.Bt + (size_t)nxt.pn * tstep : cB;
        const bool fullu = (cur.half == 0);
        for (int t = 0; t < nt; t += 2) {
            const bool last = (t == nt - 2);
            const char* a1 = cA + (size_t)(t + 1) * kstep + PG8_AJ(t + 1);
            const char* a2 = last ? nA : cA + (size_t)(t + 2) * kstep + PG8_AJ(t + 2); const char* b2 = last ? nB : cB + (size_t)(t + 2) * kstep;
            const char* a3 = a2 + kstep; const char* b3 = b2 + kstep;
            if constexpr (Epi::SEGMENTED) { if (t == 8 || t == 16) E.rescale(acc, cur, wr, wc, fr, fq, (t >> 3) - 1); }
            PG8_LDB(B0, 0, 0); PG8_LDB(B1, 0, 1); PG8_SCHED; PG8_LDA(At, 0, 0); PG8_STAGE(PG8_SA(1, 1), a1 + hstepA, voffA);
            PG8_WAIT_V(8); PG8_WAIT_L(0); PG8_BAR; PG8_MMA(0, 0, At, B0); PG8_MMA(0, 1, At, B1); PG8_BAR; PG8_SCHED;
            PG8_LDA(At, 0, 1); PG8_STAGE(PG8_SB(0, 0), b2, voffB); PG8_STAGE(PG8_SB(0, 1), b2 + hstep, voffB); PG8_STAGE(PG8_SA(0, 0), a2, voffA);
            PG8_WAIT_V(8); PG8_WAIT_L(0); PG8_BAR; if (fullu) { PG8_MMA(1, 0, At, B0); PG8_MMA(1, 1, At, B1); } PG8_BAR; PG8_SCHED;
            PG8_LDB(B0, 1, 0); PG8_LDB(B1, 1, 1); PG8_SCHED; PG8_LDA(At, 1, 0); PG8_STAGE(PG8_SA(0, 1), a2 + hstepA, voffA);
            PG8_WAIT_V(8); PG8_WAIT_L(0); PG8_BAR; PG8_MMA(0, 0, At, B0); PG8_MMA(0, 1, At, B1); PG8_BAR; PG8_SCHED;
            PG8_LDA(At, 1, 1); PG8_STAGE(PG8_SB(1, 0), b3, voffB); PG8_STAGE(PG8_SB(1, 1), b3 + hstep, voffB); PG8_STAGE(PG8_SA(1, 0), a3, voffA);
            PG8_WAIT_V(8); PG8_WAIT_L(0); PG8_BAR; if (fullu) { PG8_MMA(1, 0, At, B0); PG8_MMA(1, 1, At, B1); } PG8_BAR; PG8_SCHED;
        }
        if constexpr (ALIGN_EPI) { if (wr == 0) PG8_BAR; }
        if constexpr (!Epi::AFTER_DRAIN) E(acc, cur, wr, wc, fr, fq);
        if (!has_next) break;
#pragma unroll
        for (int a = 0; a < 2; ++a)
#pragma unroll
            for (int b = 0; b < 2; ++b)
#pragma unroll
                for (int m = 0; m < 4; ++m)
#pragma unroll
                    for (int n = 0; n < 2; ++n) acc[a][b][m][n] = (f32x4){0.f, 0.f, 0.f, 0.f};
        cur = nxt; cA = nA; cB = nB; ++ui;
        if constexpr (ALIGN_EPI) { if (wr == 1) PG8_BAR; }
    }
    PG8_WAIT_V(0);
    if constexpr (!ALIGN_EPI) { if (wr == 0) PG8_BAR; }
    PG8_BAR;
    if constexpr (Epi::AFTER_DRAIN) E.fused(acc, cur, wr, wc, fr, fq, lds, wid, lane);
#undef PG8_AJ
#undef PG8_SA
#undef PG8_SB
#undef PG8_STAGE
#undef PG8_LDA
#undef PG8_LDB
#undef PG8_MMA
#undef PG8_WAIT_V
#undef PG8_WAIT_L
#undef PG8_BAR
#undef PG8_SCHED
}
}

__device__ __forceinline__ void p0_transpose_item(const float* W, int N, bf16_t* WT, int ldt, int col_off, LAS float* scr, int item, int lane) {
    const int nblk = N / 32, kb = item / nblk, nb = item % nblk, k0 = 64 * kb, n0 = 32 * nb;
    float wv[32];
#pragma unroll
    for (int i = 0; i < 32; ++i) wv[i] = W[(size_t)(k0 + 2 * i + (lane >> 5)) * N + n0 + (lane & 31)];
#pragma unroll
    for (int i = 0; i < 32; ++i) scr[(2 * i + (lane >> 5)) * 33 + (lane & 31)] = wv[i];
    LDS_WAIT();
    const int c = lane & 7;
#pragma unroll
    for (int j = 0; j < 4; ++j) { const int n = (lane >> 3) + 8 * j; const LAS float* s = scr + (8 * c) * 33 + n;
        u32x4 o; o.x = cvt_pk_bf16(s[0 * 33], s[1 * 33]); o.y = cvt_pk_bf16(s[2 * 33], s[3 * 33]); o.z = cvt_pk_bf16(s[4 * 33], s[5 * 33]); o.w = cvt_pk_bf16(s[6 * 33], s[7 * 33]);
        *(u32x4*)(WT + (size_t)(n0 + n) * ldt + col_off + k0 + 8 * c) = o; }
    LDS_WAIT();
}
template <int NR> __device__ __forceinline__ void rms_rows_to_bf16(const float* xrow, const float* g, bf16_t* orow, size_t rstride, int lane) {
    const f32x4* gr = (const f32x4*)g + lane;
    f32x4 v[NR][4];
#pragma unroll
    for (int r = 0; r < NR; ++r)
#pragma unroll
        for (int j = 0; j < 4; ++j) v[r][j] = ((const f32x4*)(xrow + r * rstride * D) + lane)[64 * j];
    f32x4 gg[4];
#pragma unroll
    for (int j = 0; j < 4; ++j) gg[j] = gr[64 * j];
#pragma unroll
    for (int r = 0; r < NR; ++r) {
        float s = 0.f;
#pragma unroll
        for (int j = 0; j < 4; ++j) s += (v[r][j].x * v[r][j].x + v[r][j].y * v[r][j].y) + (v[r][j].z * v[r][j].z + v[r][j].w * v[r][j].w);
        const float rs = 1.0f / sqrtf(wave_sum(s) * (1.f / D) + EPS);
        u32x2* o8 = (u32x2*)(orow + r * rstride * D) + lane;
#pragma unroll
        for (int j = 0; j < 4; ++j) { u32x2 w; w.x = cvt_pk_bf16(v[r][j].x * rs * gg[j].x, v[r][j].y * rs * gg[j].y); w.y = cvt_pk_bf16(v[r][j].z * rs * gg[j].z, v[r][j].w * rs * gg[j].w); o8[64 * j] = w; }
    }
}

typedef short v4i16_t __attribute__((ext_vector_type(4)));
__device__ __forceinline__ u32x2 lds_tr(const LAS unsigned char* p) { return __builtin_bit_cast(u32x2, __builtin_amdgcn_ds_read_tr16_b64_v4i16((LAS v4i16_t*)p)); }

constexpr int WK_STRIDE = 144, WV_OFF = 384 * WK_STRIDE;
struct WinQ { u32x4 q0, q1, qn; f32x4 c0, c1, s0, s1; };
__device__ __forceinline__ WinQ win_load_q(const bf16_t* projA, const float* rope, int b, int n, int h, int r0, int fr, int fq) {
    const int qpos = n * 128 + r0 + fr; const bf16_t* qp = projA + ((size_t)b * SEQ + qpos) * PA_W + C_BQ + h * 64;
    WinQ w; w.q0 = *(const u32x4*)(qp + fq * 8); w.q1 = *(const u32x4*)(qp + 32 + fq * 8); w.qn = *(const u32x4*)(qp + (fq ^ 1) * 8);
    const f32x4* cs = (const f32x4*)(rope + qpos * 16); w.c0 = cs[0]; w.c1 = cs[1]; w.s0 = cs[2]; w.s1 = cs[3];
    return w;
}
__device__ __forceinline__ void win_attn_unit(LAS unsigned char* lds, const bf16_t* projA, const float* rope, const float* sink, bf16_t* Y, int unit, int tid) {
    asm volatile("" : "+v"(tid));
    const int b = unit >> 6, n = (unit >> 1) & 31, hk = unit & 1;
    const int lane = tid & 63, wid = __builtin_amdgcn_readfirstlane(tid >> 6), fr = lane & 15, fq = lane >> 4;
    LAS unsigned char* Ks = lds; LAS unsigned char* Vs = lds + WV_OFF;
    const int h = hk * 4 + (wid >> 1);
    WinQ nq = win_load_q(projA, rope, b, n, h, (wid & 1) * 64, fr, fq);
    {
        const int g = tid & 3;
        u32x4 kk[3][2], vv[3][2];
#pragma unroll
        for (int k = 0; k < 3; ++k) {
            const int r = (tid >> 2) + k * 128, pos = (n - 1) * 128 + r;
            kk[k][0] = (u32x4){0u, 0u, 0u, 0u}; kk[k][1] = kk[k][0]; vv[k][0] = kk[k][0]; vv[k][1] = kk[k][0];
            if (pos >= 0 && pos < SEQ) {
                const bf16_t* rowp = projA + (size_t)(b * SEQ + pos) * PA_W + hk * 64 + g * 16;
                kk[k][0] = *(const u32x4*)(rowp + C_BK); kk[k][1] = *(const u32x4*)(rowp + C_BK + 8);
                vv[k][0] = *(const u32x4*)(rowp + C_BV); vv[k][1] = *(const u32x4*)(rowp + C_BV + 8); }
        }
#pragma unroll
        for (int k = 0; k < 3; ++k) {
            const int r = (tid >> 2) + k * 128, pos = (n - 1) * 128 + r;
            u32x4 k0 = kk[k][0], k1 = kk[k][1];
            if (g == 0 && pos >= 0 && pos < SEQ) {
                const f32x4* cs = (const f32x4*)(rope + pos * 16); const f32x4 c0 = cs[0], c1 = cs[1], s0 = cs[2], s1 = cs[3];
#pragma unroll
                for (int e = 0; e < 4; ++e) {
                    const float ca = e < 2 ? c0[2 * e] : c1[2 * e - 4], cb = e < 2 ? c0[2 * e + 1] : c1[2 * e - 3];
                    const float sa = e < 2 ? s0[2 * e] : s1[2 * e - 4], sb = e < 2 ? s0[2 * e + 1] : s1[2 * e - 3];
                    const float a0 = bf_lo(k0[e]), a1 = bf_hi(k0[e]), p0 = bf_lo(k1[e]), p1 = bf_hi(k1[e]);
                    k0[e] = cvt_pk_bf16(a0 * ca - p0 * sa, a1 * cb - p1 * sb); k1[e] = cvt_pk_bf16(p0 * ca + a0 * sa, p1 * cb + a1 * sb); }
            }
            *(LAS u32x4*)(Ks + r * WK_STRIDE + g * 32) = k0; *(LAS u32x4*)(Ks + r * WK_STRIDE + g * 32 + 16) = k1;
            *(LAS u32x4*)(Vs + r * WK_STRIDE + g * 32) = vv[k][0]; *(LAS u32x4*)(Vs + r * WK_STRIDE + g * 32 + 16) = vv[k][1];
        }
    }
    __syncthreads();
    float sk = sink[h];
    asm volatile("" : "+v"(sk));
    const float sg = fq == 0 ? -1.f : 1.f; const bool rot = fq < 2;
#pragma unroll 1
    for (int mt = 0; mt < 4; ++mt) {
        const int r0 = (wid & 1) * 64 + mt * 16;
        const int qpos = n * 128 + r0 + fr; const size_t tok = (size_t)b * SEQ + qpos;
        const WinQ cq = nq;
        if (mt < 3) nq = win_load_q(projA, rope, b, n, h, r0 + 16, fr, fq);
        const bf16_t* zp = projA + tok * PA_W + C_BZ + h * 64 + fq * 4;
        u32x2 zz[4];
#pragma unroll
        for (int dt = 0; dt < 4; ++dt) zz[dt] = *(const u32x2*)(zp + dt * 16);
        u32x4 q0 = cq.q0;
#pragma unroll
        for (int e = 0; e < 4; ++e) {
            float ca = e < 2 ? cq.c0[2 * e] : cq.c1[2 * e - 4], cb = e < 2 ? cq.c0[2 * e + 1] : cq.c1[2 * e - 3];
            float sa = e < 2 ? cq.s0[2 * e] : cq.s1[2 * e - 4], sb = e < 2 ? cq.s0[2 * e + 1] : cq.s1[2 * e - 3];
            ca = rot ? ca : 1.f; cb = rot ? cb : 1.f; sa = rot ? sa * sg : 0.f; sb = rot ? sb * sg : 0.f;
            const float a0 = bf_lo(cq.q0[e]), a1 = bf_hi(cq.q0[e]), p0 = bf_lo(cq.qn[e]), p1 = bf_hi(cq.qn[e]);
            q0[e] = cvt_pk_bf16(a0 * ca + p0 * sa, a1 * cb + p1 * sb); }
        const bf16x8 qb0 = __builtin_bit_cast(bf16x8, q0), qb1 = __builtin_bit_cast(bf16x8, cq.q1);
        const int kbase = r0 < 96 ? r0 : 96;
        f32x4 s[18];
#pragma unroll
        for (int kt = 0; kt < 18; ++kt) {
            const LAS unsigned char* kp = Ks + (kbase + kt * 16 + fr) * WK_STRIDE + fq * 16;
            const bf16x8 ka = *(const LAS bf16x8*)kp, kb = *(const LAS bf16x8*)(kp + 64);
            f32x4 a = (f32x4){0.f, 0.f, 0.f, 0.f};
            a = __builtin_amdgcn_mfma_f32_16x16x32_bf16(ka, qb0, a, 0, 0, 0);
            a = __builtin_amdgcn_mfma_f32_16x16x32_bf16(kb, qb1, a, 0, 0, 0);
            s[kt] = a;
        }
        const int qrel = r0 + fr, kl0 = kbase + fq * 4, lo_lim = (n == 0) ? 128 : 0, hi_lim = (n == 31) ? 255 : 383;
        int klo = (qrel > lo_lim ? qrel : lo_lim) - kl0, kspan = (qrel + 256 < hi_lim ? qrel + 256 : hi_lim) - kl0 - klo;
        asm volatile("" : "+v"(klo), "+v"(kspan));
        const bool edge = (n == 0) || (n == 31) || (kbase != r0);
#pragma unroll
        for (int kt = 0; kt < 18; ++kt) {
            if (kt == 0 || kt >= 16 || edge) {
#pragma unroll
                for (int j = 0; j < 4; ++j) s[kt][j] = ((unsigned)(kt * 16 + j - klo) <= (unsigned)kspan) ? s[kt][j] : -INFINITY; }
        }
        float mx = -INFINITY;
#pragma unroll
        for (int kt = 0; kt < 18; ++kt)
#pragma unroll
            for (int j = 0; j < 4; ++j) mx = fmaxf(mx, s[kt][j]);
        mx = xmax16(mx); mx = xmax32(mx);
        const float mm = fmaxf(mx * 0.125f, sk);
        const float c1 = 0.125f * 1.4426950408889634f, m2 = mm * 1.4426950408889634f;
        float sum = 0.f;
#pragma unroll
        for (int kt = 0; kt < 18; ++kt)
#pragma unroll
            for (int j = 0; j < 4; ++j) { const float p = __builtin_amdgcn_exp2f(__builtin_fmaf(s[kt][j], c1, -m2)); s[kt][j] = p; sum += p; }
        sum = xsum16(sum); sum = xsum32(sum);
        const float inv = 1.0f / (sum + __builtin_amdgcn_exp2f((sk - mm) * 1.4426950408889634f));
        f32x4 o[4];
#pragma unroll
        for (int dt = 0; dt < 4; ++dt) o[dt] = (f32x4){0.f, 0.f, 0.f, 0.f};
        const LAS unsigned char* vb = Vs + (kbase + fq * 4 + (fr >> 2)) * WK_STRIDE + (fr & 3) * 8;
#pragma unroll
        for (int kp = 0; kp < 9; ++kp) {
            const bf16x8 pb = pack8(s[2 * kp], s[2 * kp + 1]);
#pragma unroll
            for (int dt = 0; dt < 4; ++dt) {
                const u32x2 lo = lds_tr(vb + kp * 32 * WK_STRIDE + dt * 32), hi = lds_tr(vb + (kp * 32 + 16) * WK_STRIDE + dt * 32);
                const u32x4 vv = (u32x4){lo.x, lo.y, hi.x, hi.y};
                o[dt] = __builtin_amdgcn_mfma_f32_16x16x32_bf16(__builtin_bit_cast(bf16x8, vv), pb, o[dt], 0, 0, 0);
            }
        }
        bf16_t* yp = Y + tok * PA_W + C_BQ + h * 64 + fq * 4;
#pragma unroll
        for (int dt = 0; dt < 4; ++dt) {
            const u32x2 z = zz[dt];
            u32x2 w; w.x = cvt_pk_bf16(o[dt][0] * inv * silu_f(bf_lo(z.x)), o[dt][1] * inv * silu_f(bf_hi(z.x)));
            w.y = cvt_pk_bf16(o[dt][2] * inv * silu_f(bf_lo(z.y)), o[dt][3] * inv * silu_f(bf_hi(z.y)));
            *(u32x2*)(yp + dt * 16) = w; }
    }
    __syncthreads();
}

constexpr int MK_STRIDE = 272, MV_OFF = 256 * MK_STRIDE;
__device__ __forceinline__ void mem_attn_unit(LAS unsigned char* lds, const bf16_t* projA, const bf16_t* mkv, bf16_t* Y, int unit, int tid) {
    asm volatile("" : "+v"(tid));
    const int b = unit >> 6, h = (unit >> 4) & 3, chunk = unit & 15;
    const int lane = tid & 63, wid = __builtin_amdgcn_readfirstlane(tid >> 6), fr = lane & 15, fq = lane >> 4;
    LAS unsigned char* Km = lds; LAS unsigned char* Vm = lds + MV_OFF;
    const size_t tok0 = (size_t)b * SEQ + chunk * 256 + wid * 32 + fr;
    u32x4 nq[4];
#pragma unroll
    for (int ks = 0; ks < 4; ++ks) nq[ks] = *(const u32x4*)(projA + tok0 * PA_W + C_MQ + h * 128 + fq * 8 + ks * 32);
#pragma unroll
    for (int half = 0; half < 2; ++half) {
        u32x4 kk[4], vv[4];
#pragma unroll
        for (int k = 0; k < 4; ++k) { const int it = tid + (half * 4 + k) * 512, r = it >> 4, c = it & 15;
            const bf16_t* rowp = mkv + (size_t)(b * MEML + r) * D + h * 128 + c * 8; kk[k] = *(const u32x4*)rowp; vv[k] = *(const u32x4*)(rowp + 512); }
#pragma unroll
        for (int k = 0; k < 4; ++k) { const int it = tid + (half * 4 + k) * 512, r = it >> 4, c = it & 15;
            *(LAS u32x4*)(Km + r * MK_STRIDE + c * 16) = kk[k]; *(LAS u32x4*)(Vm + r * MK_STRIDE + c * 16) = vv[k]; }
    }
    __syncthreads();
#pragma unroll 1
    for (int mt = 0; mt < 2; ++mt) {
        const size_t tok = tok0 + mt * 16;
        bf16x8 q[4];
#pragma unroll
        for (int ks = 0; ks < 4; ++ks) q[ks] = __builtin_bit_cast(bf16x8, nq[ks]);
        if (mt < 1) {
#pragma unroll
            for (int ks = 0; ks < 4; ++ks) nq[ks] = *(const u32x4*)(projA + (tok + 16) * PA_W + C_MQ + h * 128 + fq * 8 + ks * 32); }
        const bf16_t* zp = projA + tok * PA_W + C_MZ + h * 128 + fq * 4;
        u32x2 zz[8];
#pragma unroll
        for (int dt = 0; dt < 8; ++dt) zz[dt] = *(const u32x2*)(zp + dt * 16);
        f32x4 s[16];
#pragma unroll
        for (int kt = 0; kt < 16; ++kt) {
            const LAS unsigned char* kp = Km + (kt * 16 + fr) * MK_STRIDE + fq * 16;
            f32x4 a = (f32x4){0.f, 0.f, 0.f, 0.f};
#pragma unroll
            for (int ks = 0; ks < 4; ++ks) a = __builtin_amdgcn_mfma_f32_16x16x32_bf16(*(const LAS bf16x8*)(kp + ks * 64), q[ks], a, 0, 0, 0);
            s[kt] = a;
        }
        float mx = -INFINITY;
#pragma unroll
        for (int kt = 0; kt < 16; ++kt)
#pragma unroll
            for (int j = 0; j < 4; ++j) mx = fmaxf(mx, s[kt][j]);
        mx = xmax16(mx); mx = xmax32(mx);
        const float c1 = 0.08838834764831845f * 1.4426950408889634f, m2 = mx * c1;
        float sum = 0.f;
#pragma unroll
        for (int kt = 0; kt < 16; ++kt)
#pragma unroll
            for (int j = 0; j < 4; ++j) { const float p = __builtin_amdgcn_exp2f(__builtin_fmaf(s[kt][j], c1, -m2)); s[kt][j] = p; sum += p; }
        sum = xsum16(sum); sum = xsum32(sum);
        const float inv = 1.0f / sum;
        f32x4 o[8];
#pragma unroll
        for (int dt = 0; dt < 8; ++dt) o[dt] = (f32x4){0.f, 0.f, 0.f, 0.f};
        const LAS unsigned char* vb = Vm + (fq * 4 + (fr >> 2)) * MK_STRIDE + (fr & 3) * 8;
#pragma unroll
        for (int kp = 0; kp < 8; ++kp) {
            const bf16x8 pb = pack8(s[2 * kp], s[2 * kp + 1]);
#pragma unroll
            for (int dt = 0; dt < 8; ++dt) {
                const u32x2 lo = lds_tr(vb + kp * 32 * MK_STRIDE + dt * 32), hi = lds_tr(vb + (kp * 32 + 16) * MK_STRIDE + dt * 32);
                const u32x4 vv = (u32x4){lo.x, lo.y, hi.x, hi.y};
                o[dt] = __builtin_amdgcn_mfma_f32_16x16x32_bf16(__builtin_bit_cast(bf16x8, vv), pb, o[dt], 0, 0, 0);
            }
        }
        bf16_t* yp = Y + tok * PA_W + C_MQ + h * 128 + fq * 4;
#pragma unroll
        for (int dt = 0; dt < 8; ++dt) {
            const u32x2 z = zz[dt];
            u32x2 w; w.x = cvt_pk_bf16(o[dt][0] * inv * silu_f(bf_lo(z.x)), o[dt][1] * inv * silu_f(bf_hi(z.x)));
            w.y = cvt_pk_bf16(o[dt][2] * inv * silu_f(bf_lo(z.y)), o[dt][3] * inv * silu_f(bf_hi(z.y)));
            *(u32x2*)(yp + dt * 16) = w; }
    }
    __syncthreads();
}

__device__ __forceinline__ void cu8(const u32x4 c, const u32x4 x, float (&o)[8]) {
#pragma unroll
    for (int e = 0; e < 4; ++e) { o[2 * e] = bf_lo(c[e]) * bf_lo(x[e]); o[2 * e + 1] = bf_hi(c[e]) * bf_hi(x[e]); }
}
__device__ __forceinline__ void conv_unit(const bf16_t* projA, const float* wconv, bf16_t* Y, int unit, int tid) {
    asm volatile("" : "+v"(tid));
    const int cgp = tid & 63, tr = tid >> 6;
    const int t0 = unit * 64 + tr * 8, p0 = t0 & (SEQ - 1);
    const bf16_t* base = projA + (size_t)t0 * PA_W + cgp * 8;
    u32x4 cc[10], xx[10], bb[8], zz[8];
#define CONV_LD_CX(i) do { const bool ok = ((i) == 0) ? (p0 > 0) : (((i) == 9) ? (p0 + 8 < SEQ) : true); cc[i] = (u32x4){0u, 0u, 0u, 0u}; xx[i] = cc[i]; \
        if (ok) { cc[i] = *(const u32x4*)(base + (ptrdiff_t)((i) - 1) * PA_W + C_AC); xx[i] = *(const u32x4*)(base + (ptrdiff_t)((i) - 1) * PA_W + C_AX); } } while (0)
#define CONV_LD_BZ(i) do { bb[i] = *(const u32x4*)(base + (size_t)(i) * PA_W + C_AB); zz[i] = *(const u32x4*)(base + (size_t)(i) * PA_W + C_AZ); } while (0)
    CONV_LD_CX(0); CONV_LD_CX(1); CONV_LD_CX(2); CONV_LD_CX(3); CONV_LD_BZ(0); CONV_LD_BZ(1);
    CONV_LD_CX(4); CONV_LD_CX(5); CONV_LD_BZ(2); CONV_LD_BZ(3);
    float w0[8], w1[8], w2[8];
#pragma unroll
    for (int e = 0; e < 8; ++e) { w0[e] = wconv[cgp * 8 + e]; w1[e] = wconv[512 + cgp * 8 + e]; w2[e] = wconv[1024 + cgp * 8 + e]; }
    float prev[8], cur[8], nxt[8];
    cu8(cc[0], xx[0], prev); cu8(cc[1], xx[1], cur);
#pragma unroll
    for (int ps = 0; ps < 4; ++ps) {
        if (ps == 0) { CONV_LD_CX(6); CONV_LD_CX(7); CONV_LD_BZ(4); CONV_LD_BZ(5); }
        if (ps == 1) { CONV_LD_CX(8); CONV_LD_CX(9); CONV_LD_BZ(6); CONV_LD_BZ(7); }
#pragma unroll
        for (int k = 0; k < 2; ++k) {
            const int i = 2 * ps + k;
            cu8(cc[i + 2], xx[i + 2], nxt);
            float y[8];
#pragma unroll
            for (int e = 0; e < 4; ++e) {
                y[2 * e] = bf_lo(bb[i][e]) * (prev[2 * e] * w0[2 * e] + cur[2 * e] * w1[2 * e] + nxt[2 * e] * w2[2 * e]) * silu_f(bf_lo(zz[i][e]));
                y[2 * e + 1] = bf_hi(bb[i][e]) * (prev[2 * e + 1] * w0[2 * e + 1] + cur[2 * e + 1] * w1[2 * e + 1] + nxt[2 * e + 1] * w2[2 * e + 1]) * silu_f(bf_hi(zz[i][e])); }
            u32x4 w; w.x = cvt_pk_bf16(y[0], y[1]); w.y = cvt_pk_bf16(y[2], y[3]); w.z = cvt_pk_bf16(y[4], y[5]); w.w = cvt_pk_bf16(y[6], y[7]);
            *(u32x4*)(Y + (size_t)(t0 + i) * PA_W + C_AB + cgp * 8) = w;
#pragma unroll
            for (int e = 0; e < 8; ++e) { prev[e] = cur[e]; cur[e] = nxt[e]; }
        }
        asm volatile("" ::: "memory");
    }
#undef CONV_LD_CX
#undef CONV_LD_BZ
}

#define XB_TMO      128
#define XB_XCNT(j)  (256  + 64 * (j))
#define XB_XSUB(j)  (1280 + 64 * (j))
#define XB_XGEN(j)  (2304 + 64 * (j))
#define XB_TOP      3328
#define XB_TOPGEN   3392
#define XCD_BAR_WORDS 3456
#define XB_SPIN_CAP (1u << 18)
__device__ __forceinline__ unsigned xb_ld(unsigned* p)              { return __hip_atomic_load(p, __ATOMIC_RELAXED, __HIP_MEMORY_SCOPE_AGENT); }
__device__ __forceinline__ unsigned xb_add(unsigned* p, unsigned v) { return __hip_atomic_fetch_add(p, v, __ATOMIC_RELAXED, __HIP_MEMORY_SCOPE_AGENT); }
__device__ __forceinline__ unsigned xb_xcc_id() { return (unsigned)__builtin_amdgcn_s_getreg((3 << 11) | 20) & 0xFu; }
#define XB_SPIN(cond, bar) do { unsigned _sp = 0; while (cond) { __builtin_amdgcn_s_sleep(1); \
    if ((++_sp & 255u) == 0u) { if (xb_ld(&(bar)[XB_TMO])) break; if (_sp > XB_SPIN_CAP) { atomicAdd(&(bar)[XB_TMO], 1u); break; } } } } while (0)
struct XcdBarrier { unsigned* bar; unsigned x; volatile LAS unsigned* st; };
__device__ __forceinline__ XcdBarrier xcd_barrier_post(unsigned* bar, volatile LAS unsigned* st) {
    XcdBarrier b; b.bar = bar; b.x = xb_xcc_id(); b.st = st;
    if (threadIdx.x == 0) (void)xb_add(&bar[XB_XCNT(b.x)], 1u);
    return b;
}
__device__ __forceinline__ void xcd_barrier_complete(unsigned* bar, unsigned x, unsigned& nloc, unsigned& nx) {
    const unsigned G = gridDim.x * gridDim.y * gridDim.z;
    unsigned sum, cnt, mine, sp = 0u;
    for (;;) {
        sum = 0u; cnt = 0u; mine = 0u;
#pragma unroll
        for (unsigned j = 0; j < 16; ++j) { const unsigned c = xb_ld(&bar[XB_XCNT(j)]); sum += c; cnt += (c > 0u) ? 1u : 0u; mine = (j == x) ? c : mine; }
        if (sum == G) break;
        __builtin_amdgcn_s_sleep(1);
        if ((++sp & 255u) == 0u) { if (xb_ld(&bar[XB_TMO])) break; if (sp > XB_SPIN_CAP) { atomicAdd(&bar[XB_TMO], 1u); break; } }
    }
    nloc = mine > 0u ? mine : 1u; nx = cnt > 0u ? cnt : 1u;
}
__device__ __forceinline__ void xcd_barrier(const XcdBarrier& b) {
    asm volatile("s_waitcnt vmcnt(0)" ::: "memory");
    __syncthreads();
    if (threadIdx.x == 0) {
        unsigned* bar = b.bar;
        __builtin_amdgcn_s_waitcnt(0);
        unsigned nloc = b.st[0], nx = b.st[1];
        if (nloc == 0u) { xcd_barrier_complete(bar, b.x, nloc, nx); b.st[0] = nloc; b.st[1] = nx; }
        const unsigned old = xb_add(&bar[XB_XSUB(b.x)], 1u);
        const unsigned gen = old / nloc;
        if (old + 1u == (gen + 1u) * nloc) {
            __builtin_amdgcn_fence(__ATOMIC_RELEASE, "agent");
            asm volatile("s_waitcnt vmcnt(0)" ::: "memory");
            const unsigned og = xb_add(&bar[XB_TOP], 1u);
            const unsigned tg = og / nx;
            if (og + 1u == (tg + 1u) * nx) xb_add(&bar[XB_TOPGEN], 1u);
            else XB_SPIN(xb_ld(&bar[XB_TOPGEN]) == tg, bar);
            __builtin_amdgcn_fence(__ATOMIC_ACQUIRE, "agent");
            xb_add(&bar[XB_XGEN(b.x)], 1u);
            asm volatile("s_waitcnt vmcnt(0)" ::: "memory");
        } else {
            XB_SPIN(xb_ld(&bar[XB_XGEN(b.x)]) == gen, bar);
            __builtin_amdgcn_fence(__ATOMIC_ACQUIRE, "agent");
            asm volatile("s_waitcnt vmcnt(0)" ::: "memory");
        }
    }
    __syncthreads();
}

struct Args { const float* in[13]; float* out; unsigned char* ws; int ph_lo, ph_hi; };
static_assert(sizeof(Args) == 128, "Args has no padding");

__global__ void __launch_bounds__(NWAVES * 64, 2) hybrid_fwd(Args args) {
    extern __shared__ __attribute__((aligned(16))) unsigned char lds_raw[];
    LAS unsigned char* lds = (LAS unsigned char*)lds_raw;
    cg::grid_group grid = cg::this_grid();
    const int tid = threadIdx.x, lane = tid & 63, wave = __builtin_amdgcn_readfirstlane(tid >> 6);
    const int G = gridDim.x, bx = blockIdx.x;
    const float* x = args.in[0]; const float* mem = args.in[1]; const float* g_pre = args.in[2]; const float* w_in = args.in[3]; const float* w_conv = args.in[4];
    const float* sink = args.in[5]; const float* g_mem = args.in[6]; const float* w_mkv = args.in[7]; const float* w_up_a = args.in[8]; const float* w_up_b = args.in[9];
    const float* w_up_m = args.in[10]; const float* w_out = args.in[11]; const float* g_post = args.in[12];
    unsigned char* ws = args.ws; unsigned char* dob = (unsigned char*)args.out;
    bf16_t* WIN = (bf16_t*)(ws + WS_WIN); bf16_t* WMKV = (bf16_t*)(ws + WS_WMKV); bf16_t* WUP = (bf16_t*)(ws + WS_WUP); bf16_t* WOUT = (bf16_t*)(ws + WS_WOUT);
    float* ROPE = (float*)(ws + WS_ROPE); bf16_t* MKV = (bf16_t*)(ws + WS_MKV); bf16_t* PROJA = (bf16_t*)(ws + WS_PROJA); bf16_t* GATES = (bf16_t*)(ws + WS_GATES);
    bf16_t* MERGED = PROJA + 512; bf16_t* OUTPRE = (bf16_t*)(ws + WS_OUTPRE);
    bf16_t* HB = (bf16_t*)(dob + DO_H); bf16_t* MN = (bf16_t*)(dob + DO_MN); bf16_t* YB = PROJA;
    const int lo = args.ph_lo, hi = args.ph_hi;
#define IN(k) (lo <= (k) && (k) < hi)
    volatile LAS unsigned* MISC = (volatile LAS unsigned*)(lds + MISC_OFF);
    if (tid < 16) MISC[tid] = 0u;
    __syncthreads();
    XcdBarrier bar = xcd_barrier_post((unsigned*)(ws + WS_CTL), MISC);
    if (args.ph_hi > 1000) grid.sync();
#define SEAM(k) do { if (IN(k) && IN((k) + 1)) xcd_barrier(bar); } while (0)

    if (IN(0) && !(PH_SKIP_MASK & 1)) {
        LAS float* scr = (LAS float*)(lds + wave * 16384);
        const int gw = bx * NWAVES + wave, NGW = G * NWAVES;
        constexpr int I_IN = 16 * (IN_W / 32), I_KV = 16 * 32;
        constexpr int NITEMS = I_IN + I_KV;
        {
            int m = gw;
            for (; m + 3 * NGW < M; m += 4 * NGW) rms_rows_to_bf16<4>(x + (size_t)m * D, g_pre, HB + (size_t)m * D, (size_t)NGW, lane);
            for (; m < M; m += NGW) rms_rows_to_bf16<1>(x + (size_t)m * D, g_pre, HB + (size_t)m * D, 0, lane);
            for (int mm = gw; mm < MROWS; mm += NGW) rms_rows_to_bf16<1>(mem + (size_t)mm * D, g_mem, MN + (size_t)mm * D, 0, lane);
        }
        for (int it = gw; it < NITEMS; it += NGW) {
            int r = it;
            if (r < I_IN) { p0_transpose_item(w_in, IN_W, WIN, D, 0, scr, r, lane); continue; } r -= I_IN;
            p0_transpose_item(w_mkv, D, WMKV, D, 0, scr, r, lane);
        }
    }
    SEAM(0);

    if (IN(1) && !(PH_SKIP_MASK & 2)) {
        pg8::Gemm g{HB, WIN, M + MROWS, IN_W + D, D, D, 0, 0}; pg8::ProjOrder S{G, bx};
        pg8::EpiProj E{PROJA, GATES, MKV};
        pg8::gemm_phase<pg8::EpiProj, pg8::ProjOrder, true>(lds, g, S, E);
        const int rem = pg8::PROJ_TOTAL % G, nidle = rem ? G - rem : G, j = rem ? bx - rem : bx;
        if (j >= 0) {
            LAS float* scr = (LAS float*)(lds + wave * 16384);
            const int gw = j * NWAVES + wave, NGW = nidle * NWAVES;
            constexpr int I_UP = 8 * 32, I_OUT = 16 * 32;
            for (int it = gw; it < 3 * I_UP + I_OUT; it += NGW) {
                int r = it;
                if (r < I_UP) { p0_transpose_item(w_up_a, D, WUP, Y_W, 0, scr, r, lane); continue; } r -= I_UP;
                if (r < I_UP) { p0_transpose_item(w_up_b, D, WUP, Y_W, 512, scr, r, lane); continue; } r -= I_UP;
                if (r < I_UP) { p0_transpose_item(w_up_m, D, WUP, Y_W, 1024, scr, r, lane); continue; } r -= I_UP;
                p0_transpose_item(w_out, D, WOUT, D, 0, scr, r, lane);
            }
            for (int idx = j * 512 + tid; idx < SEQ * 8; idx += nidle * 512) {
                const int pos = idx >> 3, i = idx & 7;
                const float inv_freq = (float)exp(-(double)i * 0.125 * 13.122363377404328);
                const float ang = (float)pos * inv_freq;
                const double rev = (double)ang * 0.15915494309189535; const float fr_ = (float)(rev - rint(rev));
                ROPE[pos * 16 + i] = __builtin_amdgcn_cosf(fr_); ROPE[pos * 16 + 8 + i] = __builtin_amdgcn_sinf(fr_);
            }
        }
    }
    SEAM(1);

    if (IN(2) && !(PH_SKIP_MASK & 4)) {
#pragma unroll 1
        for (int slot = 0; slot < 3; ++slot) {
            const int which = slot == 0 ? 2 : ((slot + (bx >> 3)) & 1);
            if (which == 0) { for (int u = bx; u < 256; u += G) win_attn_unit(lds, PROJA, ROPE, sink, YB, u, tid); }
            else if (which == 1) { for (int u = bx; u < 256; u += G) mem_attn_unit(lds, PROJA, MKV, YB, u, tid); }
            else { for (int u = bx; u < 256; u += G) conv_unit(PROJA, w_conv, YB, u, tid); }
        }
    }
    SEAM(2);

    if (IN(3) && !(PH_SKIP_MASK & 8)) {
        pg8::Gemm g{PROJA + C_AB, WUP, M, D, Y_W, PA_W, (C_BQ - C_AB - 512) * 2, (C_MQ - C_BQ - 512) * 2}; pg8::StaticOrder S; S.init(M, D, G, bx);
        pg8::EpiMerge E{GATES, MERGED, PA_W};
        pg8::gemm_phase<pg8::EpiMerge, pg8::StaticOrder, true>(lds, g, S, E);
    }
    SEAM(3);

    const bool fuse_post = (G == 256);
    if (IN(4) && !(PH_SKIP_MASK & 16)) {
        pg8::Gemm g{MERGED, WOUT, M, D, D, PA_W, 0, 0}; pg8::StaticOrder S; S.init(M, D, G, bx);
        if (fuse_post) {
            pg8::EpiRmsRes E{x, g_post, args.out, (float*)(ws + WS_XBUF), (unsigned*)(ws + WS_CNT)};
            pg8::gemm_phase<pg8::EpiRmsRes, pg8::StaticOrder, true>(lds, g, S, E);
        } else {
            pg8::EpiPlain E{OUTPRE, D};
            pg8::gemm_phase<pg8::EpiPlain, pg8::StaticOrder, true>(lds, g, S, E);
        }
    }
    if (!fuse_post) SEAM(4);

    if (!fuse_post && IN(5) && !(PH_SKIP_MASK & 32)) {
        const int gw = bx * NWAVES + wave, NGW = G * NWAVES;
        const f32x4 ga = *((const f32x4*)(g_post + lane * 8)), gb = *((const f32x4*)(g_post + lane * 8 + 4));
        const f32x4 gc = *((const f32x4*)(g_post + 512 + lane * 8)), gd = *((const f32x4*)(g_post + 512 + lane * 8 + 4));
        for (int m = gw; m < M; m += NGW) {
            const bf16_t* op = OUTPRE + (size_t)m * D + lane * 8;
            const u32x4 a = *(const u32x4*)op, b = *(const u32x4*)(op + 512);
            float v[16]; float ss = 0.f;
#pragma unroll
            for (int e = 0; e < 4; ++e) { v[2 * e] = bf_lo(a[e]); v[2 * e + 1] = bf_hi(a[e]); v[8 + 2 * e] = bf_lo(b[e]); v[8 + 2 * e + 1] = bf_hi(b[e]); }
#pragma unroll
            for (int e = 0; e < 16; ++e) ss += v[e] * v[e];
            const float rs = 1.0f / sqrtf(wave_sum(ss) * (1.f / D) + EPS);
            const float* xp = x + (size_t)m * D + lane * 8; float* o = args.out + (size_t)m * D + lane * 8;
            const f32x4 x0 = *(const f32x4*)xp, x1 = *(const f32x4*)(xp + 4), x2 = *(const f32x4*)(xp + 512), x3 = *(const f32x4*)(xp + 516);
            f32x4 r0, r1, r2, r3;
#pragma unroll
            for (int e = 0; e < 4; ++e) { r0[e] = x0[e] + v[e] * rs * ga[e]; r1[e] = x1[e] + v[4 + e] * rs * gb[e]; r2[e] = x2[e] + v[8 + e] * rs * gc[e]; r3[e] = x3[e] + v[12 + e] * rs * gd[e]; }
            *(f32x4*)o = r0; *(f32x4*)(o + 4) = r1; *(f32x4*)(o + 512) = r2; *(f32x4*)(o + 516) = r3;
        }
    }
#undef IN
#undef SEAM
}

extern "C" void kernel_launch(void* const* d_in, const int* in_sizes, int n_in, void* d_out, int out_size, void* d_ws, size_t ws_size, hipStream_t stream) {
    static int grid = 0;
    if (grid == 0) {
        if (n_in != 13 || in_sizes[0] != M * D || out_size != M * D || ws_size < WS_END) { fprintf(stderr, "kernel_launch: unexpected shapes (n_in %d, in0 %d, out %d, ws %zu); nothing launched\n", n_in, n_in > 0 ? in_sizes[0] : -1, out_size, ws_size); grid = -1; return; }
        int dev = 0, cus = 0, per_cu = 0;
        if (hipGetDevice(&dev) != hipSuccess || hipDeviceGetAttribute(&cus, hipDeviceAttributeMultiprocessorCount, dev) != hipSuccess) { grid = -1; return; }
        if (hipFuncSetAttribute((const void*)hybrid_fwd, hipFuncAttributeMaxDynamicSharedMemorySize, LDS_BYTES) != hipSuccess) { fprintf(stderr, "kernel_launch: hipFuncSetAttribute failed\n"); grid = -1; return; }
        if (hipOccupancyMaxActiveBlocksPerMultiprocessor(&per_cu, (const void*)hybrid_fwd, NWAVES * 64, LDS_BYTES) != hipSuccess || per_cu < 1) { fprintf(stderr, "kernel_launch: occupancy query says %d\n", per_cu); per_cu = 1; }
        (void)hipGetLastError();
        grid = cus * 1;
    }
    if (grid < 0) return;
    if (hipMemsetAsync((char*)d_ws + WS_CTL, 0, CTL_ZERO_BYTES, stream) != hipSuccess) { fprintf(stderr, "kernel_launch: memset failed\n"); return; }
    Args a{};
    for (int i = 0; i < 13; ++i) a.in[i] = (const float*)d_in[i];
    a.out = (float*)d_out; a.ws = (unsigned char*)d_ws; a.ph_lo = 0; a.ph_hi = 6;
    void* kargs[] = {&a};
    hipError_t e = hipLaunchCooperativeKernel((const void*)hybrid_fwd, dim3(grid), dim3(NWAVES * 64), kargs, LDS_BYTES, stream);
    if (e != hipSuccess) fprintf(stderr, "kernel_launch: cooperative launch failed: %s (grid %d)\n", hipGetErrorString(e), grid);
}
```

```cpp
#include <hip/hip_runtime.h>
#include <hip/hip_cooperative_groups.h>
#include <cstdio>
#include <cstdint>
namespace cg = cooperative_groups;

#ifndef PH_SKIP_MASK
#define PH_SKIP_MASK 0
#endif

#define LAS __attribute__((address_space(3)))
typedef unsigned short bf16_t;
typedef short bf16x8 __attribute__((ext_vector_type(8)));
typedef float f32x4 __attribute__((ext_vector_type(4)));
typedef float f32x2 __attribute__((ext_vector_type(2)));
typedef unsigned u32x4 __attribute__((ext_vector_type(4)));
typedef unsigned u32x2 __attribute__((ext_vector_type(2)));

constexpr int NB = 4, SEQ = 4096, D = 1024, M = NB * SEQ;
constexpr int MEML = 256, MROWS = NB * MEML;
constexpr int PA_W = 4352, GT_W = 3072, IN_W = PA_W + GT_W;
constexpr int C_AB = 0, C_AC = 512, C_AX = 1024, C_AZ = 1536, C_BQ = 2048, C_BK = 2560, C_BV = 2688, C_BZ = 2816, C_MQ = 3328, C_MZ = 3840;
constexpr int Y_W = 1536;
constexpr float EPS = 1e-6f;

constexpr size_t WS_CTL = 0;
constexpr size_t WS_WIN = 65536;
constexpr size_t WS_WMKV = WS_WIN + (size_t)IN_W * D * 2;
constexpr size_t WS_WUP = WS_WMKV + (size_t)D * D * 2;
constexpr size_t WS_WOUT = WS_WUP + (size_t)D * Y_W * 2;
constexpr size_t WS_ROPE = WS_WOUT + (size_t)D * D * 2;
constexpr size_t WS_MKV = WS_ROPE + (size_t)SEQ * 16 * 4;
constexpr size_t WS_PROJA = 25165824;
constexpr size_t WS_GATES = WS_PROJA + (size_t)M * PA_W * 2;
constexpr size_t WS_END = WS_GATES + (size_t)M * GT_W * 2;
static_assert(WS_MKV + (size_t)MROWS * D * 2 <= WS_PROJA && WS_END == 268435456, "d_ws map");
constexpr size_t WS_CNT = 16384;
constexpr size_t WS_XBUF = WS_ROPE;
constexpr size_t WS_OUTPRE = WS_GATES;
constexpr size_t DO_H = 0, DO_MN = (size_t)M * D * 2, DO_Y = 0;

constexpr int LDS_BYTES = 143360;
constexpr int NWAVES = 8;
constexpr int MISC_OFF = LDS_BYTES - 64;
constexpr size_t CTL_ZERO_BYTES = 32768;

__device__ __forceinline__ unsigned cvt_pk_bf16(float lo, float hi) { unsigned r; asm volatile("v_cvt_pk_bf16_f32 %0, %1, %2" : "=v"(r) : "v"(lo), "v"(hi)); return r; }
__device__ __forceinline__ float bf_lo(unsigned w) { return __uint_as_float(w << 16); }
__device__ __forceinline__ float bf_hi(unsigned w) { return __uint_as_float(w & 0xffff0000u); }
__device__ __forceinline__ float silu_f(float z) { return z * __builtin_amdgcn_rcpf(1.0f + __expf(-z)); }
__device__ __forceinline__ bf16x8 pack8(f32x4 a, f32x4 b) { u32x4 w; w.x = cvt_pk_bf16(a[0], a[1]); w.y = cvt_pk_bf16(a[2], a[3]); w.z = cvt_pk_bf16(b[0], b[1]); w.w = cvt_pk_bf16(b[2], b[3]); return __builtin_bit_cast(bf16x8, w); }
__device__ __forceinline__ float wave_sum(float v) {
#pragma unroll
    for (int o = 1; o < 64; o <<= 1) v += __shfl_xor(v, o);
    return v;
}
#define LDS_WAIT() asm volatile("s_waitcnt lgkmcnt(0)" ::: "memory")
__device__ __forceinline__ float xmax16(float v) { auto r = __builtin_amdgcn_permlane16_swap(__float_as_uint(v), __float_as_uint(v), false, false); return fmaxf(__uint_as_float(r[0]), __uint_as_float(r[1])); }
__device__ __forceinline__ float xmax32(float v) { auto r = __builtin_amdgcn_permlane32_swap(__float_as_uint(v), __float_as_uint(v), false, false); return fmaxf(__uint_as_float(r[0]), __uint_as_float(r[1])); }
__device__ __forceinline__ float xsum16(float v) { auto r = __builtin_amdgcn_permlane16_swap(__float_as_uint(v), __float_as_uint(v), false, false); return __uint_as_float(r[0]) + __uint_as_float(r[1]); }
__device__ __forceinline__ float xsum32(float v) { auto r = __builtin_amdgcn_permlane32_swap(__float_as_uint(v), __float_as_uint(v), false, false); return __uint_as_float(r[0]) + __uint_as_float(r[1]); }

namespace pg8 {
constexpr int BM = 256, BK = 64, HALF = 128, HTB = HALF * BK * 2, STAGE_BYTES = 8 * HTB, NXCD = 8, WGM = 8;
__host__ __device__ __forceinline__ int lds_byte(int r, int c) { const int st = (r >> 4) * 2 + (c >> 5), rr = r & 15, cc = c & 31, ob = rr * 64 + cc * 2; return st * 1024 + (ob ^ (((ob >> 9) & 1) << 5)); }
__host__ __device__ __forceinline__ void stage_rc(int b, int& R, int& C) { const int st = b / 1024, sb = b % 1024, swz = sb ^ (((sb >> 9) & 1) << 5); R = (st >> 1) * 16 + swz / 64; C = (st & 1) * 32 + (swz % 64) / 2; }
__host__ __device__ __forceinline__ int perm32(int rho) { const int n = rho >> 4, i = rho & 15; return 8 * (i >> 2) + 4 * n + (i & 3); }

struct Unit { int pm, pn, half; };
struct Gemm { const bf16_t* A; const bf16_t* Bt; int M, N, K; int lda; int j1, j2; };

struct StaticOrder {
    int nM, nN, nwg, G, c;
    __device__ void init(int M_, int N_, int G_, int c_) { nM = M_ / BM; nN = N_ / BM; nwg = nM * nN; G = G_; c = c_; }
    __device__ bool next(int i, Unit& u) const {
        const long L = (long)i * G + c; if (L >= nwg) return false;
        int wgid = (int)L; { const int q = nwg / NXCD, r = nwg % NXCD, xcd = wgid % NXCD, off = wgid / NXCD; wgid = (xcd < r ? xcd * (q + 1) : r * (q + 1) + (xcd - r) * q) + off; }
        const int nig = WGM * nN, gid = wgid / nig, fm = gid * WGM, gsz = (nM - fm) < WGM ? (nM - fm) : WGM;
        u.pm = fm + ((wgid % nig) % gsz); u.pn = (wgid % nig) / gsz; u.half = 0; return true;
    }
};
constexpr int PROJ_FULL = 1792, PROJ_TOTAL = PROJ_FULL + 160;
struct ProjOrder {
    int G, c;
    __device__ bool next(int i, Unit& u) const {
        const int L = i * G + c; if (L >= PROJ_TOTAL) return false;
        const int F = L - 160, o = F >> 3, e = L, uid = e >> 1, m = uid - 64;
        const bool full = L >= 160, t28 = uid < 64;
        const int pm = full ? (F & 7) * 8 + (o & 7) : (t28 ? uid : 64 + (m >> 2));
        const int pn = full ? 27 - (o >> 3) : (t28 ? 28 : 29 + (m & 3));
        const int half = full ? 0 : 1 + (e & 1);
        u.pm = pm; u.pn = pn; u.half = half; return true;
    }
};

struct EpiProj {
    static constexpr bool PERM = true, SEGMENTED = false, AFTER_DRAIN = false;
    bf16_t* projA; bf16_t* gates; bf16_t* mkv;
    __device__ __forceinline__ void rescale(f32x4 (&)[2][2][4][2], const Unit&, int, int, int, int, int) const {}
    __device__ __forceinline__ void operator()(f32x4 (&acc)[2][2][4][2], const Unit& u, int wr, int wc, int fr, int fq) const {
        bf16_t* base; int ldc, colt, rowt = u.pm * BM;
        if (u.pn < 17) { base = projA; ldc = PA_W; colt = u.pn * BM; }
        else if (u.pn < 29) { base = gates; ldc = GT_W; colt = (u.pn - 17) * BM; }
        else { base = mkv; ldc = D; colt = (u.pn - 29) * BM; rowt -= M; }
        const int row0 = rowt + (u.half == 2 ? HALF : 0) + wr * 64 + fr, col0 = colt + wc * 32 + 8 * fq;
        const bool is_gate = (u.pn >= 17) && (u.pn < 29);
#pragma unroll
        for (int ai = 0; ai < 2; ++ai) {
            if (ai == 1 && u.half) break;
#pragma unroll
            for (int m = 0; m < 4; ++m) { bf16_t* rowp = base + (size_t)(row0 + ai * HALF + m * 16) * ldc + col0;
#pragma unroll
                for (int bj = 0; bj < 2; ++bj) { f32x4 v0 = acc[ai][bj][m][0], v1 = acc[ai][bj][m][1];
                    if (is_gate) {
#pragma unroll
                        for (int e = 0; e < 4; ++e) { v0[e] = 1.0f + __builtin_amdgcn_exp2f(__builtin_amdgcn_fmed3f(v0[e], -60.f, 60.f) * -1.4426950408889634f);
                            v1[e] = 1.0f + __builtin_amdgcn_exp2f(__builtin_amdgcn_fmed3f(v1[e], -60.f, 60.f) * -1.4426950408889634f); } }
                    u32x4 w; w.x = cvt_pk_bf16(v0[0], v0[1]); w.y = cvt_pk_bf16(v0[2], v0[3]); w.z = cvt_pk_bf16(v1[0], v1[1]); w.w = cvt_pk_bf16(v1[2], v1[3]);
                    *(u32x4*)(rowp + bj * HALF) = w; } }
        }
    }
};
struct EpiPlain {
    static constexpr bool PERM = true, SEGMENTED = false, AFTER_DRAIN = false;
    bf16_t* O; int ldc;
    __device__ __forceinline__ void rescale(f32x4 (&)[2][2][4][2], const Unit&, int, int, int, int, int) const {}
    __device__ __forceinline__ void operator()(f32x4 (&acc)[2][2][4][2], const Unit& u, int wr, int wc, int fr, int fq) const {
        const int row0 = u.pm * BM + wr * 64 + fr, col0 = u.pn * BM + wc * 32 + 8 * fq;
#pragma unroll
        for (int ai = 0; ai < 2; ++ai)
#pragma unroll
            for (int m = 0; m < 4; ++m) { bf16_t* rowp = O + (size_t)(row0 + ai * HALF + m * 16) * ldc + col0;
#pragma unroll
                for (int bj = 0; bj < 2; ++bj) { const f32x4 v0 = acc[ai][bj][m][0], v1 = acc[ai][bj][m][1];
                    u32x4 w; w.x = cvt_pk_bf16(v0[0], v0[1]); w.y = cvt_pk_bf16(v0[2], v0[3]); w.z = cvt_pk_bf16(v1[0], v1[1]); w.w = cvt_pk_bf16(v1[2], v1[3]);
                    *(u32x4*)(rowp + bj * HALF) = w; } }
    }
};
struct EpiMerge {
    static constexpr bool PERM = true, SEGMENTED = true, AFTER_DRAIN = false;
    const bf16_t* gates; bf16_t* O; int ldc;
    static __device__ __forceinline__ float e_neg(float l) { l = fminf(fmaxf(l, -60.f), 60.f); return __expf(-l); }
    __device__ __forceinline__ void rescale(f32x4 (&acc)[2][2][4][2], const Unit& u, int wr, int wc, int fr, int fq, int seg) const {
        const int row0 = u.pm * BM + wr * 64 + fr, col0 = u.pn * BM + wc * 32 + 8 * fq;
        const bf16_t* gp0 = gates + (size_t)row0 * GT_W + col0 + seg * D;
        asm volatile("" : "+v"(gp0));
#pragma unroll
        for (int ai = 0; ai < 2; ++ai)
#pragma unroll
            for (int m = 0; m < 4; ++m) { const bf16_t* gp = gp0 + (size_t)(ai * HALF + m * 16) * GT_W;
#pragma unroll
                for (int bj = 0; bj < 2; ++bj) { const u32x4 la = *(const u32x4*)(gp + bj * HALF), lb = *(const u32x4*)(gp + bj * HALF + D);
#pragma unroll
                    for (int e = 0; e < 4; ++e) { const float r0 = bf_lo(lb[e]) * __builtin_amdgcn_rcpf(bf_lo(la[e]));
                        const float r1 = bf_hi(lb[e]) * __builtin_amdgcn_rcpf(bf_hi(la[e]));
                        acc[ai][bj][m][e >> 1][(e & 1) * 2] *= r0; acc[ai][bj][m][e >> 1][(e & 1) * 2 + 1] *= r1; } }
                if (m == 3) asm volatile("" ::: "memory"); }
    }
    __device__ __forceinline__ void operator()(f32x4 (&acc)[2][2][4][2], const Unit& u, int wr, int wc, int fr, int fq) const {
        const int row0 = u.pm * BM + wr * 64 + fr, col0 = u.pn * BM + wc * 32 + 8 * fq;
        u32x4 lg[2][4][2];
#pragma unroll
        for (int ai = 0; ai < 2; ++ai)
#pragma unroll
            for (int m = 0; m < 4; ++m)
#pragma unroll
                for (int bj = 0; bj < 2; ++bj) lg[ai][m][bj] = *(const u32x4*)(gates + (size_t)(row0 + ai * HALF + m * 16) * GT_W + col0 + 2 * D + bj * HALF);
#pragma unroll
        for (int ai = 0; ai < 2; ++ai)
#pragma unroll
            for (int m = 0; m < 4; ++m) { const size_t r = (size_t)(row0 + ai * HALF + m * 16); bf16_t* rowp = O + r * ldc + col0;
#pragma unroll
                for (int bj = 0; bj < 2; ++bj) { const u32x4 la = lg[ai][m][bj]; float v[8];
#pragma unroll
                    for (int e = 0; e < 4; ++e) { v[2 * e] = acc[ai][bj][m][e >> 1][(e & 1) * 2] * __builtin_amdgcn_rcpf(bf_lo(la[e]));
                        v[2 * e + 1] = acc[ai][bj][m][e >> 1][(e & 1) * 2 + 1] * __builtin_amdgcn_rcpf(bf_hi(la[e])); }
                    u32x4 w; w.x = cvt_pk_bf16(v[0], v[1]); w.y = cvt_pk_bf16(v[2], v[3]); w.z = cvt_pk_bf16(v[4], v[5]); w.w = cvt_pk_bf16(v[6], v[7]);
                    *(u32x4*)(rowp + bj * HALF) = w; } }
    }
};

struct EpiRmsRes {
    static constexpr bool PERM = true, SEGMENTED = false, AFTER_DRAIN = true;
    const float* x; const float* g; float* out; float* xbuf; unsigned* cnt;
    __device__ __forceinline__ void rescale(f32x4 (&)[2][2][4][2], const Unit&, int, int, int, int, int) const {}
    __device__ __forceinline__ void operator()(f32x4 (&)[2][2][4][2], const Unit&, int, int, int, int) const {}
    __device__ __forceinline__ void fused(f32x4 (&acc)[2][2][4][2], const Unit& u, int wr, int wc, int fr, int fq, LAS unsigned char* lds, int wid, int lane) const {
        LAS float* P = (LAS float*)lds;
        LAS float* S = (LAS float*)(lds + 4096);
        const int tid = wid * 64 + lane;
        const int col0 = u.pn * BM + wc * 32 + 8 * fq;
        f32x4 pre[4][2][2];
#pragma unroll
        for (int m = 0; m < 4; ++m) { const size_t off = (size_t)(u.pm * BM + wr * 64 + m * 16 + fr) * D + col0;
#pragma unroll
            for (int bj = 0; bj < 2; ++bj)
#pragma unroll
                for (int n = 0; n < 2; ++n) pre[m][bj][n] = *(const f32x4*)(x + off + bj * HALF + 4 * n); }
#pragma unroll
        for (int ai = 0; ai < 2; ++ai)
#pragma unroll
            for (int m = 0; m < 4; ++m) { float q = 0.f;
#pragma unroll
                for (int bj = 0; bj < 2; ++bj)
#pragma unroll
                    for (int n = 0; n < 2; ++n) { const f32x4 v = acc[ai][bj][m][n]; q += (v[0] * v[0] + v[1] * v[1]) + (v[2] * v[2] + v[3] * v[3]); }
                q += __shfl_xor(q, 16); q += __shfl_xor(q, 32);
                if (fq == 0) P[(ai * HALF + wr * 64 + m * 16 + fr) * 4 + wc] = q; }
        asm volatile("s_waitcnt lgkmcnt(0)" ::: "memory"); __builtin_amdgcn_s_barrier(); asm volatile("" ::: "memory");
        if (tid < 256) { const float t = (P[tid * 4] + P[tid * 4 + 1]) + (P[tid * 4 + 2] + P[tid * 4 + 3]);
            __hip_atomic_store(xbuf + ((u.pm * 4 + u.pn) * 256 + tid), t, __ATOMIC_RELAXED, __HIP_MEMORY_SCOPE_AGENT); }
        asm volatile("s_waitcnt vmcnt(0)" ::: "memory");
        if (lane == 0) __hip_atomic_fetch_add(cnt + 64 * u.pm, 1u, __ATOMIC_RELAXED, __HIP_MEMORY_SCOPE_AGENT);
        if (wid == 0) {
            unsigned sp = 0;
            while ((unsigned)__builtin_amdgcn_readfirstlane(__hip_atomic_load(cnt + 64 * u.pm, __ATOMIC_RELAXED, __HIP_MEMORY_SCOPE_AGENT)) < 32u) { __builtin_amdgcn_s_sleep(2); if (++sp > (1u << 20)) break; }
            __builtin_amdgcn_fence(__ATOMIC_ACQUIRE, "agent");
        }
        asm volatile("s_waitcnt vmcnt(0) lgkmcnt(0)" ::: "memory"); __builtin_amdgcn_s_barrier(); asm volatile("" ::: "memory");
        if (tid < 256) { float t = 0.f;
#pragma unroll
            for (int pn = 0; pn < 4; ++pn) t += __hip_atomic_load(xbuf + ((u.pm * 4 + pn) * 256 + tid), __ATOMIC_RELAXED, __HIP_MEMORY_SCOPE_AGENT);
            S[tid] = 1.0f / sqrtf(t * (1.0f / D) + EPS); }
        asm volatile("s_waitcnt lgkmcnt(0)" ::: "memory"); __builtin_amdgcn_s_barrier(); asm volatile("" ::: "memory");
        f32x4 gv[2][2];
#pragma unroll
        for (int bj = 0; bj < 2; ++bj)
#pragma unroll
            for (int n = 0; n < 2; ++n) gv[bj][n] = *(const f32x4*)(g + col0 + bj * HALF + 4 * n);
#pragma unroll
        for (int m = 0; m < 4; ++m) { const int r = wr * 64 + m * 16 + fr; const float rs = S[r]; const size_t off = (size_t)(u.pm * BM + r) * D + col0;
#pragma unroll
            for (int bj = 0; bj < 2; ++bj)
#pragma unroll
                for (int n = 0; n < 2; ++n) *(f32x4*)(out + off + bj * HALF + 4 * n) = pre[m][bj][n] + acc[0][bj][m][n] * rs * gv[bj][n]; }
        asm volatile("" ::: "memory");
#pragma unroll
        for (int m = 0; m < 4; ++m) { const size_t off = (size_t)(u.pm * BM + HALF + wr * 64 + m * 16 + fr) * D + col0;
#pragma unroll
            for (int bj = 0; bj < 2; ++bj)
#pragma unroll
                for (int n = 0; n < 2; ++n) pre[m][bj][n] = *(const f32x4*)(x + off + bj * HALF + 4 * n); }
#pragma unroll
        for (int m = 0; m < 4; ++m) { const int r = HALF + wr * 64 + m * 16 + fr; const float rs = S[r]; const size_t off = (size_t)(u.pm * BM + r) * D + col0;
#pragma unroll
            for (int bj = 0; bj < 2; ++bj)
#pragma unroll
                for (int n = 0; n < 2; ++n) *(f32x4*)(out + off + bj * HALF + 4 * n) = pre[m][bj][n] + acc[1][bj][m][n] * rs * gv[bj][n]; }
    }
};

template <class Epi, class Sched, bool ALIGN_EPI = true>
__device__ __forceinline__ void gemm_phase(LAS unsigned char* lds, const Gemm g, const Sched& S, const Epi& E) {
    const int tid = threadIdx.x, wid = __builtin_amdgcn_readfirstlane(tid >> 6), lane = tid & 63, wr = wid >> 2, wc = wid & 3, fr = lane & 15, fq = lane >> 4;
    const int K = g.K, nt = K / BK;
    unsigned voffA[2], voffB[2];
#pragma unroll
    for (int i = 0; i < 2; ++i) { int R, C; stage_rc(tid * 16 + i * 8192, R, C); const int Rb = Epi::PERM ? ((R & ~31) + perm32(R & 31)) : R;
        voffA[i] = (unsigned)(R * g.lda + C) * 2u; voffB[i] = (unsigned)(Rb * K + C) * 2u; }
    const size_t kstep = (size_t)(BK * 2);
    const size_t hstep = (size_t)HALF * K * 2, tstep = 2 * hstep;
    const size_t hstepA = (size_t)HALF * g.lda * 2, tstepA = 2 * hstepA;
#define PG8_AJ(t) (Epi::SEGMENTED ? (size_t)(((t) >= 8 ? g.j1 : 0) + ((t) >= 16 ? g.j2 : 0)) : (size_t)0)
    const unsigned ldsw = (unsigned)wid * 1024u;
    const int aoff = lds_byte(wr * 64 + fr, fq * 8), boff = lds_byte(wc * 32 + fr, fq * 8);
#define PG8_SA(b, h) (((b) * 2 + (h)) * HTB)
#define PG8_SB(b, h) ((4 + (b) * 2 + (h)) * HTB)
#define PG8_STAGE(bufoff, gbase, voff) do { _Pragma("unroll") for (int _i = 0; _i < 2; ++_i) \
        __builtin_amdgcn_global_load_lds((const unsigned*)((const char*)(gbase) + (voff)[_i]), (LAS unsigned*)(lds + (bufoff) + ldsw + _i * 8192), 16, 0, 0); } while (0)
#define PG8_LDA(dst, b, h) do { _Pragma("unroll") for (int m = 0; m < 4; ++m) _Pragma("unroll") for (int k = 0; k < 2; ++k) dst[m][k] = *(const LAS bf16x8*)(lds + PG8_SA(b, h) + aoff + m * 2048 + k * 1024); } while (0)
#define PG8_LDB(dst, b, h) do { _Pragma("unroll") for (int n = 0; n < 2; ++n) _Pragma("unroll") for (int k = 0; k < 2; ++k) dst[n][k] = *(const LAS bf16x8*)(lds + PG8_SB(b, h) + boff + n * 2048 + k * 1024); } while (0)
#define PG8_MMA(ai, bj, At, Bt) do { __builtin_amdgcn_s_setprio(1); _Pragma("unroll") for (int m = 0; m < 4; ++m) _Pragma("unroll") for (int n = 0; n < 2; ++n) _Pragma("unroll") for (int k = 0; k < 2; ++k) \
        acc[ai][bj][m][n] = __builtin_amdgcn_mfma_f32_16x16x32_bf16(Bt[n][k], At[m][k], acc[ai][bj][m][n], 0, 0, 0); __builtin_amdgcn_s_setprio(0); } while (0)
#define PG8_WAIT_V(n) asm volatile("s_waitcnt vmcnt(" #n ")" ::: "memory")
#define PG8_WAIT_L(n) asm volatile("s_waitcnt lgkmcnt(" #n ")" ::: "memory")
#define PG8_BAR __builtin_amdgcn_s_barrier()
#define PG8_SCHED __builtin_amdgcn_sched_barrier(0)
    Unit cur, nxt; int ui = 0;
    if (!S.next(0, cur)) return;
    f32x4 acc[2][2][4][2];
#pragma unroll
    for (int a = 0; a < 2; ++a)
#pragma unroll
        for (int b = 0; b < 2; ++b)
#pragma unroll
            for (int m = 0; m < 4; ++m)
#pragma unroll
                for (int n = 0; n < 2; ++n) acc[a][b][m][n] = (f32x4){0.f, 0.f, 0.f, 0.f};
    bf16x8 At[4][2], B0[2][2], B1[2][2];
    const char* cA = (const char*)g.A + (size_t)cur.pm * tstepA + (cur.half == 2 ? hstepA : 0); const char* cB = (const char*)g.Bt + (size_t)cur.pn * tstep;
    PG8_STAGE(PG8_SB(0, 0), cB, voffB); PG8_STAGE(PG8_SB(0, 1), cB + hstep, voffB); PG8_STAGE(PG8_SA(0, 0), cA, voffA); PG8_STAGE(PG8_SA(0, 1), cA + hstepA, voffA);
    if (wr == 1) PG8_BAR;
    PG8_WAIT_V(2); PG8_BAR;
    PG8_STAGE(PG8_SB(1, 0), cB + kstep, voffB); PG8_STAGE(PG8_SA(1, 0), cA + kstep, voffA); PG8_STAGE(PG8_SB(1, 1), cB + hstep + kstep, voffB);
    PG8_WAIT_V(6); PG8_BAR;
    for (;;) {
        const bool has_next = S.next(ui + 1, nxt);
        const char* nA = has_next ? (const char*)g.A + (size_t)nxt.pm * tstepA + (nxt.half == 2 ? hstepA : 0) : cA; const char* nB = has_next ? (const char*)g.Bt + (size_t)nxt.pn * tstep : cB;
        const bool fullu = (cur.half == 0);
        for (int t = 0; t < nt; t += 2) {
            const bool last = (t == nt - 2);
            const char* a1 = cA + (size_t)(t + 1) * kstep + PG8_AJ(t + 1);
            const char* a2 = last ? nA : cA + (size_t)(t + 2) * kstep + PG8_AJ(t + 2); const char* b2 = last ? nB : cB + (size_t)(t + 2) * kstep;
            const char* a3 = a2 + kstep; const char* b3 = b2 + kstep;
            if constexpr (Epi::SEGMENTED) { if (t == 8 || t == 16) E.rescale(acc, cur, wr, wc, fr, fq, (t >> 3) - 1); }
            PG8_LDB(B0, 0, 0); PG8_LDB(B1, 0, 1); PG8_SCHED; PG8_LDA(At, 0, 0); PG8_STAGE(PG8_SA(1, 1), a1 + hstepA, voffA);
            PG8_WAIT_V(8); PG8_WAIT_L(0); PG8_BAR; PG8_MMA(0, 0, At, B0); PG8_MMA(0, 1, At, B1); PG8_BAR; PG8_SCHED;
            PG8_LDA(At, 0, 1); PG8_STAGE(PG8_SB(0, 0), b2, voffB); PG8_STAGE(PG8_SB(0, 1), b2 + hstep, voffB); PG8_STAGE(PG8_SA(0, 0), a2, voffA);
            PG8_WAIT_V(8); PG8_WAIT_L(0); PG8_BAR; if (fullu) { PG8_MMA(1, 0, At, B0); PG8_MMA(1, 1, At, B1); } PG8_BAR; PG8_SCHED;
            PG8_LDB(B0, 1, 0); PG8_LDB(B1, 1, 1); PG8_SCHED; PG8_LDA(At, 1, 0); PG8_STAGE(PG8_SA(0, 1), a2 + hstepA, voffA);
            PG8_WAIT_V(8); PG8_WAIT_L(0); PG8_BAR; PG8_MMA(0, 0, At, B0); PG8_MMA(0, 1, At, B1); PG8_BAR; PG8_SCHED;
            PG8_LDA(At, 1, 1); PG8_STAGE(PG8_SB(1, 0), b3, voffB); PG8_STAGE(PG8_SB(1, 1), b3 + hstep, voffB); PG8_STAGE(PG8_SA(1, 0), a3, voffA);
            PG8_WAIT_V(8); PG8_WAIT_L(0); PG8_BAR; if (fullu) { PG8_MMA(1, 0, At, B0); PG8_MMA(1, 1, At, B1); } PG8_BAR; PG8_SCHED;
        }
        if constexpr (ALIGN_EPI) { if (wr == 0) PG8_BAR; }
        if constexpr (!Epi::AFTER_DRAIN) E(acc, cur, wr, wc, fr, fq);
        if (!has_next) break;
#pragma unroll
        for (int a = 0; a < 2; ++a)
#pragma unroll
            for (int b = 0; b < 2; ++b)
#pragma unroll
                for (int m = 0; m < 4; ++m)
#pragma unroll
                    for (int n = 0; n < 2; ++n) acc[a][b][m][n] = (f32x4){0.f, 0.f, 0.f, 0.f};
        cur = nxt; cA = nA; cB = nB; ++ui;
        if constexpr (ALIGN_EPI) { if (wr == 1) PG8_BAR; }
    }
    PG8_WAIT_V(0);
    if constexpr (!ALIGN_EPI) { if (wr == 0) PG8_BAR; }
    PG8_BAR;
    if constexpr (Epi::AFTER_DRAIN) E.fused(acc, cur, wr, wc, fr, fq, lds, wid, lane);
#undef PG8_AJ
#undef PG8_SA
#undef PG8_SB
#undef PG8_STAGE
#undef PG8_LDA
#undef PG8_LDB
#undef PG8_MMA
#undef PG8_WAIT_V
#undef PG8_WAIT_L
#undef PG8_BAR
#undef PG8_SCHED
}
}

__device__ __forceinline__ void p0_transpose_item(const float* W, int N, bf16_t* WT, int ldt, int col_off, LAS float* scr, int item, int lane) {
    const int nblk = N / 32, kb = item / nblk, nb = item % nblk, k0 = 64 * kb, n0 = 32 * nb;
    float wv[32];
#pragma unroll
    for (int i = 0; i < 32; ++i) wv[i] = __builtin_nontemporal_load(W + (size_t)(k0 + 2 * i + (lane >> 5)) * N + n0 + (lane & 31));
#pragma unroll
    for (int i = 0; i < 32; ++i) scr[(2 * i + (lane >> 5)) * 33 + (lane & 31)] = wv[i];
    LDS_WAIT();
    const int c = lane & 7;
#pragma unroll
    for (int j = 0; j < 4; ++j) { const int n = (lane >> 3) + 8 * j; const LAS float* s = scr + (8 * c) * 33 + n;
        u32x4 o; o.x = cvt_pk_bf16(s[0 * 33], s[1 * 33]); o.y = cvt_pk_bf16(s[2 * 33], s[3 * 33]); o.z = cvt_pk_bf16(s[4 * 33], s[5 * 33]); o.w = cvt_pk_bf16(s[6 * 33], s[7 * 33]);
        *(u32x4*)(WT + (size_t)(n0 + n) * ldt + col_off + k0 + 8 * c) = o; }
    LDS_WAIT();
}
template <int NR> __device__ __forceinline__ void rms_rows_to_bf16(const float* xrow, const float* g, bf16_t* orow, size_t rstride, int lane) {
    const f32x4* gr = (const f32x4*)g + lane;
    f32x4 v[NR][4];
#pragma unroll
    for (int r = 0; r < NR; ++r)
#pragma unroll
        for (int j = 0; j < 4; ++j) v[r][j] = __builtin_nontemporal_load((const f32x4*)(xrow + r * rstride * D) + lane + 64 * j);
    f32x4 gg[4];
#pragma unroll
    for (int j = 0; j < 4; ++j) gg[j] = gr[64 * j];
#pragma unroll
    for (int r = 0; r < NR; ++r) {
        float s = 0.f;
#pragma unroll
        for (int j = 0; j < 4; ++j) s += (v[r][j].x * v[r][j].x + v[r][j].y * v[r][j].y) + (v[r][j].z * v[r][j].z + v[r][j].w * v[r][j].w);
        const float rs = 1.0f / sqrtf(wave_sum(s) * (1.f / D) + EPS);
        u32x2* o8 = (u32x2*)(orow + r * rstride * D) + lane;
#pragma unroll
        for (int j = 0; j < 4; ++j) { u32x2 w; w.x = cvt_pk_bf16(v[r][j].x * rs * gg[j].x, v[r][j].y * rs * gg[j].y); w.y = cvt_pk_bf16(v[r][j].z * rs * gg[j].z, v[r][j].w * rs * gg[j].w); o8[64 * j] = w; }
    }
}

typedef short v4i16_t __attribute__((ext_vector_type(4)));
__device__ __forceinline__ u32x2 lds_tr(const LAS unsigned char* p) { return __builtin_bit_cast(u32x2, __builtin_amdgcn_ds_read_tr16_b64_v4i16((LAS v4i16_t*)p)); }

constexpr int WK_STRIDE = 144, WV_OFF = 384 * WK_STRIDE;
struct WinQ { u32x4 q0, q1, qn; f32x4 c0, c1, s0, s1; };
__device__ __forceinline__ WinQ win_load_q(const bf16_t* projA, const float* rope, int b, int n, int h, int r0, int fr, int fq) {
    const int qpos = n * 128 + r0 + fr; const bf16_t* qp = projA + ((size_t)b * SEQ + qpos) * PA_W + C_BQ + h * 64;
    WinQ w; w.q0 = *(const u32x4*)(qp + fq * 8); w.q1 = *(const u32x4*)(qp + 32 + fq * 8); w.qn = *(const u32x4*)(qp + (fq ^ 1) * 8);
    const f32x4* cs = (const f32x4*)(rope + qpos * 16); w.c0 = cs[0]; w.c1 = cs[1]; w.s0 = cs[2]; w.s1 = cs[3];
    return w;
}
__device__ __forceinline__ void win_attn_unit(LAS unsigned char* lds, const bf16_t* projA, const float* rope, const float* sink, bf16_t* Y, int unit, int tid) {
    asm volatile("" : "+v"(tid));
    const int b = unit >> 6, n = (unit >> 1) & 31, hk = unit & 1;
    const int lane = tid & 63, wid = __builtin_amdgcn_readfirstlane(tid >> 6), fr = lane & 15, fq = lane >> 4;
    LAS unsigned char* Ks = lds; LAS unsigned char* Vs = lds + WV_OFF;
    const int h = hk * 4 + (wid >> 1);
    WinQ nq = win_load_q(projA, rope, b, n, h, (wid & 1) * 64, fr, fq);
    {
        const int g = tid & 3;
        u32x4 kk[3][2], vv[3][2];
#pragma unroll
        for (int k = 0; k < 3; ++k) {
            const int r = (tid >> 2) + k * 128, pos = (n - 1) * 128 + r;
            kk[k][0] = (u32x4){0u, 0u, 0u, 0u}; kk[k][1] = kk[k][0]; vv[k][0] = kk[k][0]; vv[k][1] = kk[k][0];
            if (pos >= 0 && pos < SEQ) {
                const bf16_t* rowp = projA + (size_t)(b * SEQ + pos) * PA_W + hk * 64 + g * 16;
                kk[k][0] = *(const u32x4*)(rowp + C_BK); kk[k][1] = *(const u32x4*)(rowp + C_BK + 8);
                vv[k][0] = *(const u32x4*)(rowp + C_BV); vv[k][1] = *(const u32x4*)(rowp + C_BV + 8); }
        }
#pragma unroll
        for (int k = 0; k < 3; ++k) {
            const int r = (tid >> 2) + k * 128, pos = (n - 1) * 128 + r;
            u32x4 k0 = kk[k][0], k1 = kk[k][1];
            if (g == 0 && pos >= 0 && pos < SEQ) {
                const f32x4* cs = (const f32x4*)(rope + pos * 16); const f32x4 c0 = cs[0], c1 = cs[1], s0 = cs[2], s1 = cs[3];
#pragma unroll
                for (int e = 0; e < 4; ++e) {
                    const float ca = e < 2 ? c0[2 * e] : c1[2 * e - 4], cb = e < 2 ? c0[2 * e + 1] : c1[2 * e - 3];
                    const float sa = e < 2 ? s0[2 * e] : s1[2 * e - 4], sb = e < 2 ? s0[2 * e + 1] : s1[2 * e - 3];
                    const float a0 = bf_lo(k0[e]), a1 = bf_hi(k0[e]), p0 = bf_lo(k1[e]), p1 = bf_hi(k1[e]);
                    k0[e] = cvt_pk_bf16(a0 * ca - p0 * sa, a1 * cb - p1 * sb); k1[e] = cvt_pk_bf16(p0 * ca + a0 * sa, p1 * cb + a1 * sb); }
            }
            *(LAS u32x4*)(Ks + r * WK_STRIDE + g * 32) = k0; *(LAS u32x4*)(Ks + r * WK_STRIDE + g * 32 + 16) = k1;
            *(LAS u32x4*)(Vs + r * WK_STRIDE + g * 32) = vv[k][0]; *(LAS u32x4*)(Vs + r * WK_STRIDE + g * 32 + 16) = vv[k][1];
        }
    }
    __syncthreads();
    float sk = sink[h];
    asm volatile("" : "+v"(sk));
    const float sg = fq == 0 ? -1.f : 1.f; const bool rot = fq < 2;
#pragma unroll 1
    for (int mt = 0; mt < 4; ++mt) {
        const int r0 = (wid & 1) * 64 + mt * 16;
        const int qpos = n * 128 + r0 + fr; const size_t tok = (size_t)b * SEQ + qpos;
        const WinQ cq = nq;
        if (mt < 3) nq = win_load_q(projA, rope, b, n, h, r0 + 16, fr, fq);
        const bf16_t* zp = projA + tok * PA_W + C_BZ + h * 64 + fq * 4;
        u32x2 zz[4];
#pragma unroll
        for (int dt = 0; dt < 4; ++dt) zz[dt] = *(const u32x2*)(zp + dt * 16);
        u32x4 q0 = cq.q0;
#pragma unroll
        for (int e = 0; e < 4; ++e) {
            float ca = e < 2 ? cq.c0[2 * e] : cq.c1[2 * e - 4], cb = e < 2 ? cq.c0[2 * e + 1] : cq.c1[2 * e - 3];
            float sa = e < 2 ? cq.s0[2 * e] : cq.s1[2 * e - 4], sb = e < 2 ? cq.s0[2 * e + 1] : cq.s1[2 * e - 3];
            ca = rot ? ca : 1.f; cb = rot ? cb : 1.f; sa = rot ? sa * sg : 0.f; sb = rot ? sb * sg : 0.f;
            const float a0 = bf_lo(cq.q0[e]), a1 = bf_hi(cq.q0[e]), p0 = bf_lo(cq.qn[e]), p1 = bf_hi(cq.qn[e]);
            q0[e] = cvt_pk_bf16(a0 * ca + p0 * sa, a1 * cb + p1 * sb); }
        const bf16x8 qb0 = __builtin_bit_cast(bf16x8, q0), qb1 = __builtin_bit_cast(bf16x8, cq.q1);
        const int kbase = r0 < 96 ? r0 : 96;
        f32x4 s[18];
#pragma unroll
        for (int kt = 0; kt < 18; ++kt) {
            const LAS unsigned char* kp = Ks + (kbase + kt * 16 + fr) * WK_STRIDE + fq * 16;
            const bf16x8 ka = *(const LAS bf16x8*)kp, kb = *(const LAS bf16x8*)(kp + 64);
            f32x4 a = (f32x4){0.f, 0.f, 0.f, 0.f};
            a = __builtin_amdgcn_mfma_f32_16x16x32_bf16(ka, qb0, a, 0, 0, 0);
            a = __builtin_amdgcn_mfma_f32_16x16x32_bf16(kb, qb1, a, 0, 0, 0);
            s[kt] = a;
        }
        const int qrel = r0 + fr, kl0 = kbase + fq * 4, lo_lim = (n == 0) ? 128 : 0, hi_lim = (n == 31) ? 255 : 383;
        int klo = (qrel > lo_lim ? qrel : lo_lim) - kl0, kspan = (qrel + 256 < hi_lim ? qrel + 256 : hi_lim) - kl0 - klo;
        asm volatile("" : "+v"(klo), "+v"(kspan));
        const bool edge = (n == 0) || (n == 31) || (kbase != r0);
#pragma unroll
        for (int kt = 0; kt < 18; ++kt) {
            if (kt == 0 || kt >= 16 || edge) {
#pragma unroll
                for (int j = 0; j < 4; ++j) s[kt][j] = ((unsigned)(kt * 16 + j - klo) <= (unsigned)kspan) ? s[kt][j] : -INFINITY; }
        }
        float mx = -INFINITY;
#pragma unroll
        for (int kt = 0; kt < 18; ++kt)
#pragma unroll
            for (int j = 0; j < 4; ++j) mx = fmaxf(mx, s[kt][j]);
        mx = xmax16(mx); mx = xmax32(mx);
        const float mm = fmaxf(mx * 0.125f, sk);
        const float c1 = 0.125f * 1.4426950408889634f, m2 = mm * 1.4426950408889634f;
        float sum = 0.f;
#pragma unroll
        for (int kt = 0; kt < 18; ++kt)
#pragma unroll
            for (int j = 0; j < 4; ++j) { const float p = __builtin_amdgcn_exp2f(__builtin_fmaf(s[kt][j], c1, -m2)); s[kt][j] = p; sum += p; }
        sum = xsum16(sum); sum = xsum32(sum);
        const float inv = 1.0f / (sum + __builtin_amdgcn_exp2f((sk - mm) * 1.4426950408889634f));
        f32x4 o[4];
#pragma unroll
        for (int dt = 0; dt < 4; ++dt) o[dt] = (f32x4){0.f, 0.f, 0.f, 0.f};
        const LAS unsigned char* vb = Vs + (kbase + fq * 4 + (fr >> 2)) * WK_STRIDE + (fr & 3) * 8;
#pragma unroll
        for (int kp = 0; kp < 9; ++kp) {
            const bf16x8 pb = pack8(s[2 * kp], s[2 * kp + 1]);
#pragma unroll
            for (int dt = 0; dt < 4; ++dt) {
                const u32x2 lo = lds_tr(vb + kp * 32 * WK_STRIDE + dt * 32), hi = lds_tr(vb + (kp * 32 + 16) * WK_STRIDE + dt * 32);
                const u32x4 vv = (u32x4){lo.x, lo.y, hi.x, hi.y};
                o[dt] = __builtin_amdgcn_mfma_f32_16x16x32_bf16(__builtin_bit_cast(bf16x8, vv), pb, o[dt], 0, 0, 0);
            }
        }
        bf16_t* yp = Y + tok * PA_W + C_BQ + h * 64 + fq * 4;
#pragma unroll
        for (int dt = 0; dt < 4; ++dt) {
            const u32x2 z = zz[dt];
            u32x2 w; w.x = cvt_pk_bf16(o[dt][0] * inv * silu_f(bf_lo(z.x)), o[dt][1] * inv * silu_f(bf_hi(z.x)));
            w.y = cvt_pk_bf16(o[dt][2] * inv * silu_f(bf_lo(z.y)), o[dt][3] * inv * silu_f(bf_hi(z.y)));
            *(u32x2*)(yp + dt * 16) = w; }
    }
    __syncthreads();
}

constexpr int MK_STRIDE = 272, MV_OFF = 256 * MK_STRIDE;
__device__ __forceinline__ void mem_attn_unit(LAS unsigned char* lds, const bf16_t* projA, const bf16_t* mkv, bf16_t* Y, int unit, int tid) {
    asm volatile("" : "+v"(tid));
    const int b = unit >> 6, h = (unit >> 4) & 3, chunk = unit & 15;
    const int lane = tid & 63, wid = __builtin_amdgcn_readfirstlane(tid >> 6), fr = lane & 15, fq = lane >> 4;
    LAS unsigned char* Km = lds; LAS unsigned char* Vm = lds + MV_OFF;
    const size_t tok0 = (size_t)b * SEQ + chunk * 256 + wid * 32 + fr;
    u32x4 nq[4];
#pragma unroll
    for (int ks = 0; ks < 4; ++ks) nq[ks] = *(const u32x4*)(projA + tok0 * PA_W + C_MQ + h * 128 + fq * 8 + ks * 32);
#pragma unroll
    for (int half = 0; half < 2; ++half) {
        u32x4 kk[4], vv[4];
#pragma unroll
        for (int k = 0; k < 4; ++k) { const int it = tid + (half * 4 + k) * 512, r = it >> 4, c = it & 15;
            const bf16_t* rowp = mkv + (size_t)(b * MEML + r) * D + h * 128 + c * 8; kk[k] = *(const u32x4*)rowp; vv[k] = *(const u32x4*)(rowp + 512); }
#pragma unroll
        for (int k = 0; k < 4; ++k) { const int it = tid + (half * 4 + k) * 512, r = it >> 4, c = it & 15;
            *(LAS u32x4*)(Km + r * MK_STRIDE + c * 16) = kk[k]; *(LAS u32x4*)(Vm + r * MK_STRIDE + c * 16) = vv[k]; }
    }
    __syncthreads();
#pragma unroll 1
    for (int mt = 0; mt < 2; ++mt) {
        const size_t tok = tok0 + mt * 16;
        bf16x8 q[4];
#pragma unroll
        for (int ks = 0; ks < 4; ++ks) q[ks] = __builtin_bit_cast(bf16x8, nq[ks]);
        if (mt < 1) {
#pragma unroll
            for (int ks = 0; ks < 4; ++ks) nq[ks] = *(const u32x4*)(projA + (tok + 16) * PA_W + C_MQ + h * 128 + fq * 8 + ks * 32); }
        const bf16_t* zp = projA + tok * PA_W + C_MZ + h * 128 + fq * 4;
        u32x2 zz[8];
#pragma unroll
        for (int dt = 0; dt < 8; ++dt) zz[dt] = *(const u32x2*)(zp + dt * 16);
        f32x4 s[16];
#pragma unroll
        for (int kt = 0; kt < 16; ++kt) {
            const LAS unsigned char* kp = Km + (kt * 16 + fr) * MK_STRIDE + fq * 16;
            f32x4 a = (f32x4){0.f, 0.f, 0.f, 0.f};
#pragma unroll
            for (int ks = 0; ks < 4; ++ks) a = __builtin_amdgcn_mfma_f32_16x16x32_bf16(*(const LAS bf16x8*)(kp + ks * 64), q[ks], a, 0, 0, 0);
            s[kt] = a;
        }
        float mx = -INFINITY;
#pragma unroll
        for (int kt = 0; kt < 16; ++kt)
#pragma unroll
            for (int j = 0; j < 4; ++j) mx = fmaxf(mx, s[kt][j]);
        mx = xmax16(mx); mx = xmax32(mx);
        const float c1 = 0.08838834764831845f * 1.4426950408889634f, m2 = mx * c1;
        float sum = 0.f;
#pragma unroll
        for (int kt = 0; kt < 16; ++kt)
#pragma unroll
            for (int j = 0; j < 4; ++j) { const float p = __builtin_amdgcn_exp2f(__builtin_fmaf(s[kt][j], c1, -m2)); s[kt][j] = p; sum += p; }
        sum = xsum16(sum); sum = xsum32(sum);
        const float inv = 1.0f / sum;
        f32x4 o[8];
#pragma unroll
        for (int dt = 0; dt < 8; ++dt) o[dt] = (f32x4){0.f, 0.f, 0.f, 0.f};
        const LAS unsigned char* vb = Vm + (fq * 4 + (fr >> 2)) * MK_STRIDE + (fr & 3) * 8;
#pragma unroll
        for (int kp = 0; kp < 8; ++kp) {
            const bf16x8 pb = pack8(s[2 * kp], s[2 * kp + 1]);
#pragma unroll
            for (int dt = 0; dt < 8; ++dt) {
                const u32x2 lo = lds_tr(vb + kp * 32 * MK_STRIDE + dt * 32), hi = lds_tr(vb + (kp * 32 + 16) * MK_STRIDE + dt * 32);
                const u32x4 vv = (u32x4){lo.x, lo.y, hi.x, hi.y};
                o[dt] = __builtin_amdgcn_mfma_f32_16x16x32_bf16(__builtin_bit_cast(bf16x8, vv), pb, o[dt], 0, 0, 0);
            }
        }
        bf16_t* yp = Y + tok * PA_W + C_MQ + h * 128 + fq * 4;
#pragma unroll
        for (int dt = 0; dt < 8; ++dt) {
            const u32x2 z = zz[dt];
            u32x2 w; w.x = cvt_pk_bf16(o[dt][0] * inv * silu_f(bf_lo(z.x)), o[dt][1] * inv * silu_f(bf_hi(z.x)));
            w.y = cvt_pk_bf16(o[dt][2] * inv * silu_f(bf_lo(z.y)), o[dt][3] * inv * silu_f(bf_hi(z.y)));
            *(u32x2*)(yp + dt * 16) = w; }
    }
    __syncthreads();
}

__device__ __forceinline__ void cu8(const u32x4 c, const u32x4 x, float (&o)[8]) {
#pragma unroll
    for (int e = 0; e < 4; ++e) { o[2 * e] = bf_lo(c[e]) * bf_lo(x[e]); o[2 * e + 1] = bf_hi(c[e]) * bf_hi(x[e]); }
}
__device__ __forceinline__ void conv_unit(const bf16_t* projA, const float* wconv, bf16_t* Y, int unit, int tid) {
    asm volatile("" : "+v"(tid));
    const int cgp = tid & 63, tr = tid >> 6;
    const int t0 = unit * 64 + tr * 8, p0 = t0 & (SEQ - 1);
    const bf16_t* base = projA + (size_t)t0 * PA_W + cgp * 8;
    u32x4 cc[10], xx[10], bb[8], zz[8];
#define CONV_LD_CX(i) do { const bool ok = ((i) == 0) ? (p0 > 0) : (((i) == 9) ? (p0 + 8 < SEQ) : true); cc[i] = (u32x4){0u, 0u, 0u, 0u}; xx[i] = cc[i]; \
        if (ok) { cc[i] = *(const u32x4*)(base + (ptrdiff_t)((i) - 1) * PA_W + C_AC); xx[i] = *(const u32x4*)(base + (ptrdiff_t)((i) - 1) * PA_W + C_AX); } } while (0)
#define CONV_LD_BZ(i) do { bb[i] = *(const u32x4*)(base + (size_t)(i) * PA_W + C_AB); zz[i] = *(const u32x4*)(base + (size_t)(i) * PA_W + C_AZ); } while (0)
    CONV_LD_CX(0); CONV_LD_CX(1); CONV_LD_CX(2); CONV_LD_CX(3); CONV_LD_BZ(0); CONV_LD_BZ(1);
    CONV_LD_CX(4); CONV_LD_CX(5); CONV_LD_BZ(2); CONV_LD_BZ(3);
    float w0[8], w1[8], w2[8];
#pragma unroll
    for (int e = 0; e < 8; ++e) { w0[e] = wconv[cgp * 8 + e]; w1[e] = wconv[512 + cgp * 8 + e]; w2[e] = wconv[1024 + cgp * 8 + e]; }
    float prev[8], cur[8], nxt[8];
    cu8(cc[0], xx[0], prev); cu8(cc[1], xx[1], cur);
#pragma unroll
    for (int ps = 0; ps < 4; ++ps) {
        if (ps == 0) { CONV_LD_CX(6); CONV_LD_CX(7); CONV_LD_BZ(4); CONV_LD_BZ(5); }
        if (ps == 1) { CONV_LD_CX(8); CONV_LD_CX(9); CONV_LD_BZ(6); CONV_LD_BZ(7); }
#pragma unroll
        for (int k = 0; k < 2; ++k) {
            const int i = 2 * ps + k;
            cu8(cc[i + 2], xx[i + 2], nxt);
            float y[8];
#pragma unroll
            for (int e = 0; e < 4; ++e) {
                y[2 * e] = bf_lo(bb[i][e]) * (prev[2 * e] * w0[2 * e] + cur[2 * e] * w1[2 * e] + nxt[2 * e] * w2[2 * e]) * silu_f(bf_lo(zz[i][e]));
                y[2 * e + 1] = bf_hi(bb[i][e]) * (prev[2 * e + 1] * w0[2 * e + 1] + cur[2 * e + 1] * w1[2 * e + 1] + nxt[2 * e + 1] * w2[2 * e + 1]) * silu_f(bf_hi(zz[i][e])); }
            u32x4 w; w.x = cvt_pk_bf16(y[0], y[1]); w.y = cvt_pk_bf16(y[2], y[3]); w.z = cvt_pk_bf16(y[4], y[5]); w.w = cvt_pk_bf16(y[6], y[7]);
            *(u32x4*)(Y + (size_t)(t0 + i) * PA_W + C_AB + cgp * 8) = w;
#pragma unroll
            for (int e = 0; e < 8; ++e) { prev[e] = cur[e]; cur[e] = nxt[e]; }
        }
        asm volatile("" ::: "memory");
    }
#undef CONV_LD_CX
#undef CONV_LD_BZ
}

#define XB_TMO      128
#define XB_XCNT(j)  (256  + 64 * (j))
#define XB_XSUB(j)  (1280 + 64 * (j))
#define XB_XGEN(j)  (2304 + 64 * (j))
#define XB_TOP      3328
#define XB_TOPGEN   3392
#define XCD_BAR_WORDS 3456
#define XB_SPIN_CAP (1u << 18)
__device__ __forceinline__ unsigned xb_ld(unsigned* p)              { return __hip_atomic_load(p, __ATOMIC_RELAXED, __HIP_MEMORY_SCOPE_AGENT); }
__device__ __forceinline__ unsigned xb_add(unsigned* p, unsigned v) { return __hip_atomic_fetch_add(p, v, __ATOMIC_RELAXED, __HIP_MEMORY_SCOPE_AGENT); }
__device__ __forceinline__ unsigned xb_xcc_id() { return (unsigned)__builtin_amdgcn_s_getreg((3 << 11) | 20) & 0xFu; }
#define XB_SPIN(cond, bar) do { unsigned _sp = 0; while (cond) { __builtin_amdgcn_s_sleep(1); \
    if ((++_sp & 255u) == 0u) { if (xb_ld(&(bar)[XB_TMO])) break; if (_sp > XB_SPIN_CAP) { atomicAdd(&(bar)[XB_TMO], 1u); break; } } } } while (0)
struct XcdBarrier { unsigned* bar; unsigned x; volatile LAS unsigned* st; };
__device__ __forceinline__ XcdBarrier xcd_barrier_post(unsigned* bar, volatile LAS unsigned* st) {
    XcdBarrier b; b.bar = bar; b.x = xb_xcc_id(); b.st = st;
    if (threadIdx.x == 0) (void)xb_add(&bar[XB_XCNT(b.x)], 1u);
    return b;
}
__device__ __forceinline__ void xcd_barrier_complete(unsigned* bar, unsigned x, unsigned& nloc, unsigned& nx) {
    const unsigned G = gridDim.x * gridDim.y * gridDim.z;
    unsigned sum, cnt, mine, sp = 0u;
    for (;;) {
        sum = 0u; cnt = 0u; mine = 0u;
#pragma unroll
        for (unsigned j = 0; j < 16; ++j) { const unsigned c = xb_ld(&bar[XB_XCNT(j)]); sum += c; cnt += (c > 0u) ? 1u : 0u; mine = (j == x) ? c : mine; }
        if (sum == G) break;
        __builtin_amdgcn_s_sleep(1);
        if ((++sp & 255u) == 0u) { if (xb_ld(&bar[XB_TMO])) break; if (sp > XB_SPIN_CAP) { atomicAdd(&bar[XB_TMO], 1u); break; } }
    }
    nloc = mine > 0u ? mine : 1u; nx = cnt > 0u ? cnt : 1u;
}
__device__ __forceinline__ void xcd_barrier(const XcdBarrier& b) {
    asm volatile("s_waitcnt vmcnt(0)" ::: "memory");
    __syncthreads();
    if (threadIdx.x == 0) {
        unsigned* bar = b.bar;
        __builtin_amdgcn_s_waitcnt(0);
        unsigned nloc = b.st[0], nx = b.st[1];
        if (nloc == 0u) { xcd_barrier_complete(bar, b.x, nloc, nx); b.st[0] = nloc; b.st[1] = nx; }
        const unsigned old = xb_add(&bar[XB_XSUB(b.x)], 1u);
        const unsigned gen = old / nloc;
        if (old + 1u == (gen + 1u) * nloc) {
            __builtin_amdgcn_fence(__ATOMIC_RELEASE, "agent");
            asm volatile("s_waitcnt vmcnt(0)" ::: "memory");
            const unsigned og = xb_add(&bar[XB_TOP], 1u);
            const unsigned tg = og / nx;
            if (og + 1u == (tg + 1u) * nx) xb_add(&bar[XB_TOPGEN], 1u);
            else XB_SPIN(xb_ld(&bar[XB_TOPGEN]) == tg, bar);
            __builtin_amdgcn_fence(__ATOMIC_ACQUIRE, "agent");
            xb_add(&bar[XB_XGEN(b.x)], 1u);
            asm volatile("s_waitcnt vmcnt(0)" ::: "memory");
        } else {
            XB_SPIN(xb_ld(&bar[XB_XGEN(b.x)]) == gen, bar);
            __builtin_amdgcn_fence(__ATOMIC_ACQUIRE, "agent");
            asm volatile("s_waitcnt vmcnt(0)" ::: "memory");
        }
    }
    __syncthreads();
}

struct Args { const float* in[13]; float* out; unsigned char* ws; int ph_lo, ph_hi; };
static_assert(sizeof(Args) == 128, "Args has no padding");

__global__ void __launch_bounds__(NWAVES * 64, 2) hybrid_fwd(Args args) {
    extern __shared__ __attribute__((aligned(16))) unsigned char lds_raw[];
    LAS unsigned char* lds = (LAS unsigned char*)lds_raw;
    cg::grid_group grid = cg::this_grid();
    const int tid = threadIdx.x, lane = tid & 63, wave = __builtin_amdgcn_readfirstlane(tid >> 6);
    const int G = gridDim.x, bx = blockIdx.x;
    const float* x = args.in[0]; const float* mem = args.in[1]; const float* g_pre = args.in[2]; const float* w_in = args.in[3]; const float* w_conv = args.in[4];
    const float* sink = args.in[5]; const float* g_mem = args.in[6]; const float* w_mkv = args.in[7]; const float* w_up_a = args.in[8]; const float* w_up_b = args.in[9];
    const float* w_up_m = args.in[10]; const float* w_out = args.in[11]; const float* g_post = args.in[12];
    unsigned char* ws = args.ws; unsigned char* dob = (unsigned char*)args.out;
    bf16_t* WIN = (bf16_t*)(ws + WS_WIN); bf16_t* WMKV = (bf16_t*)(ws + WS_WMKV); bf16_t* WUP = (bf16_t*)(ws + WS_WUP); bf16_t* WOUT = (bf16_t*)(ws + WS_WOUT);
    float* ROPE = (float*)(ws + WS_ROPE); bf16_t* MKV = (bf16_t*)(ws + WS_MKV); bf16_t* PROJA = (bf16_t*)(ws + WS_PROJA); bf16_t* GATES = (bf16_t*)(ws + WS_GATES);
    bf16_t* MERGED = PROJA + 512; bf16_t* OUTPRE = (bf16_t*)(ws + WS_OUTPRE);
    bf16_t* HB = (bf16_t*)(dob + DO_H); bf16_t* MN = (bf16_t*)(dob + DO_MN); bf16_t* YB = PROJA;
    const int lo = args.ph_lo, hi = args.ph_hi;
#define IN(k) (lo <= (k) && (k) < hi)
    volatile LAS unsigned* MISC = (volatile LAS unsigned*)(lds + MISC_OFF);
    if (tid < 16) MISC[tid] = 0u;
    __syncthreads();
    XcdBarrier bar = xcd_barrier_post((unsigned*)(ws + WS_CTL), MISC);
    if (args.ph_hi > 1000) grid.sync();
#define SEAM(k) do { if (IN(k) && IN((k) + 1)) xcd_barrier(bar); } while (0)

    if (IN(0) && !(PH_SKIP_MASK & 1)) {
        LAS float* scr = (LAS float*)(lds + wave * 16384);
        const int gw = bx * NWAVES + wave, NGW = G * NWAVES;
        constexpr int I_IN = 16 * (IN_W / 32), I_KV = 16 * 32;
        constexpr int NITEMS = I_IN + I_KV;
        {
            int m = gw;
            for (; m + 3 * NGW < M; m += 4 * NGW) rms_rows_to_bf16<4>(x + (size_t)m * D, g_pre, HB + (size_t)m * D, (size_t)NGW, lane);
            for (; m < M; m += NGW) rms_rows_to_bf16<1>(x + (size_t)m * D, g_pre, HB + (size_t)m * D, 0, lane);
            for (int mm = gw; mm < MROWS; mm += NGW) rms_rows_to_bf16<1>(mem + (size_t)mm * D, g_mem, MN + (size_t)mm * D, 0, lane);
        }
        for (int it = gw; it < NITEMS; it += NGW) {
            int r = it;
            if (r < I_IN) { p0_transpose_item(w_in, IN_W, WIN, D, 0, scr, r, lane); continue; } r -= I_IN;
            p0_transpose_item(w_mkv, D, WMKV, D, 0, scr, r, lane);
        }
    }
    SEAM(0);

    if (IN(1) && !(PH_SKIP_MASK & 2)) {
        pg8::Gemm g{HB, WIN, M + MROWS, IN_W + D, D, D, 0, 0}; pg8::ProjOrder S{G, bx};
        pg8::EpiProj E{PROJA, GATES, MKV};
        pg8::gemm_phase<pg8::EpiProj, pg8::ProjOrder, true>(lds, g, S, E);
        const int rem = pg8::PROJ_TOTAL % G, nidle = rem ? G - rem : G, j = rem ? bx - rem : bx;
        if (j >= 0) {
            LAS float* scr = (LAS float*)(lds + wave * 16384);
            const int gw = j * NWAVES + wave, NGW = nidle * NWAVES;
            constexpr int I_UP = 8 * 32, I_OUT = 16 * 32;
            for (int it = gw; it < 3 * I_UP + I_OUT; it += NGW) {
                int r = it;
                if (r < I_UP) { p0_transpose_item(w_up_a, D, WUP, Y_W, 0, scr, r, lane); continue; } r -= I_UP;
                if (r < I_UP) { p0_transpose_item(w_up_b, D, WUP, Y_W, 512, scr, r, lane); continue; } r -= I_UP;
                if (r < I_UP) { p0_transpose_item(w_up_m, D, WUP, Y_W, 1024, scr, r, lane); continue; } r -= I_UP;
                p0_transpose_item(w_out, D, WOUT, D, 0, scr, r, lane);
            }
            for (int idx = j * 512 + tid; idx < SEQ * 8; idx += nidle * 512) {
                const int pos = idx >> 3, i = idx & 7;
                const float inv_freq = (float)exp(-(double)i * 0.125 * 13.122363377404328);
                const float ang = (float)pos * inv_freq;
                const double rev = (double)ang * 0.15915494309189535; const float fr_ = (float)(rev - rint(rev));
                ROPE[pos * 16 + i] = __builtin_amdgcn_cosf(fr_); ROPE[pos * 16 + 8 + i] = __builtin_amdgcn_sinf(fr_);
            }
        }
    }
    SEAM(1);

    if (IN(2) && !(PH_SKIP_MASK & 4)) {
#pragma unroll 1
        for (int slot = 0; slot < 3; ++slot) {
            const int which = (slot + (bx >> 3)) % 3;
            if (which == 0) { for (int u = bx; u < 256; u += G) win_attn_unit(lds, PROJA, ROPE, sink, YB, u, tid); }
            else if (which == 1) { for (int u = bx; u < 256; u += G) mem_attn_unit(lds, PROJA, MKV, YB, u, tid); }
            else { for (int u = bx; u < 256; u += G) conv_unit(PROJA, w_conv, YB, u, tid); }
        }
    }
    SEAM(2);

    if (IN(3) && !(PH_SKIP_MASK & 8)) {
        pg8::Gemm g{PROJA + C_AB, WUP, M, D, Y_W, PA_W, (C_BQ - C_AB - 512) * 2, (C_MQ - C_BQ - 512) * 2}; pg8::StaticOrder S; S.init(M, D, G, bx);
        pg8::EpiMerge E{GATES, MERGED, PA_W};
        pg8::gemm_phase<pg8::EpiMerge, pg8::StaticOrder, true>(lds, g, S, E);
    }
    SEAM(3);

    const bool fuse_post = (G == 256);
    if (IN(4) && !(PH_SKIP_MASK & 16)) {
        pg8::Gemm g{MERGED, WOUT, M, D, D, PA_W, 0, 0}; pg8::StaticOrder S; S.init(M, D, G, bx);
        if (fuse_post) {
            pg8::EpiRmsRes E{x, g_post, args.out, (float*)(ws + WS_XBUF), (unsigned*)(ws + WS_CNT)};
            pg8::gemm_phase<pg8::EpiRmsRes, pg8::StaticOrder, true>(lds, g, S, E);
        } else {
            pg8::EpiPlain E{OUTPRE, D};
            pg8::gemm_phase<pg8::EpiPlain, pg8::StaticOrder, true>(lds, g, S, E);
        }
    }
    if (!fuse_post) SEAM(4);

    if (!fuse_post && IN(5) && !(PH_SKIP_MASK & 32)) {
        const int gw = bx * NWAVES + wave, NGW = G * NWAVES;
        const f32x4 ga = *((const f32x4*)(g_post + lane * 8)), gb = *((const f32x4*)(g_post + lane * 8 + 4));
        const f32x4 gc = *((const f32x4*)(g_post + 512 + lane * 8)), gd = *((const f32x4*)(g_post + 512 + lane * 8 + 4));
        for (int m = gw; m < M; m += NGW) {
            const bf16_t* op = OUTPRE + (size_t)m * D + lane * 8;
            const u32x4 a = *(const u32x4*)op, b = *(const u32x4*)(op + 512);
            float v[16]; float ss = 0.f;
#pragma unroll
            for (int e = 0; e < 4; ++e) { v[2 * e] = bf_lo(a[e]); v[2 * e + 1] = bf_hi(a[e]); v[8 + 2 * e] = bf_lo(b[e]); v[8 + 2 * e + 1] = bf_hi(b[e]); }
#pragma unroll
            for (int e = 0; e < 16; ++e) ss += v[e] * v[e];
            const float rs = 1.0f / sqrtf(wave_sum(ss) * (1.f / D) + EPS);
            const float* xp = x + (size_t)m * D + lane * 8; float* o = args.out + (size_t)m * D + lane * 8;
            const f32x4 x0 = *(const f32x4*)xp, x1 = *(const f32x4*)(xp + 4), x2 = *(const f32x4*)(xp + 512), x3 = *(const f32x4*)(xp + 516);
            f32x4 r0, r1, r2, r3;
#pragma unroll
            for (int e = 0; e < 4; ++e) { r0[e] = x0[e] + v[e] * rs * ga[e]; r1[e] = x1[e] + v[4 + e] * rs * gb[e]; r2[e] = x2[e] + v[8 + e] * rs * gc[e]; r3[e] = x3[e] + v[12 + e] * rs * gd[e]; }
            *(f32x4*)o = r0; *(f32x4*)(o + 4) = r1; *(f32x4*)(o + 512) = r2; *(f32x4*)(o + 516) = r3;
        }
    }
#undef IN
#undef SEAM
}

extern "C" void kernel_launch(void* const* d_in, const int* in_sizes, int n_in, void* d_out, int out_size, void* d_ws, size_t ws_size, hipStream_t stream) {
    static int grid = 0;
    if (grid == 0) {
        if (n_in != 13 || in_sizes[0] != M * D || out_size != M * D || ws_size < WS_END) { fprintf(stderr, "kernel_launch: unexpected shapes (n_in %d, in0 %d, out %d, ws %zu); nothing launched\n", n_in, n_in > 0 ? in_sizes[0] : -1, out_size, ws_size); grid = -1; return; }
        int dev = 0, cus = 0, per_cu = 0;
        if (hipGetDevice(&dev) != hipSuccess || hipDeviceGetAttribute(&cus, hipDeviceAttributeMultiprocessorCount, dev) != hipSuccess) { grid = -1; return; }
        if (hipFuncSetAttribute((const void*)hybrid_fwd, hipFuncAttributeMaxDynamicSharedMemorySize, LDS_BYTES) != hipSuccess) { fprintf(stderr, "kernel_launch: hipFuncSetAttribute failed\n"); grid = -1; return; }
        if (hipOccupancyMaxActiveBlocksPerMultiprocessor(&per_cu, (const void*)hybrid_fwd, NWAVES * 64, LDS_BYTES) != hipSuccess || per_cu < 1) { fprintf(stderr, "kernel_launch: occupancy query says %d\n", per_cu); per_cu = 1; }
        (void)hipGetLastError();
        grid = cus * 1;
    }
    if (grid < 0) return;
    if (hipMemsetAsync((char*)d_ws + WS_CTL, 0, CTL_ZERO_BYTES, stream) != hipSuccess) { fprintf(stderr, "kernel_launch: memset failed\n"); return; }
    Args a{};
    for (int i = 0; i < 13; ++i) a.in[i] = (const float*)d_in[i];
    a.out = (float*)d_out; a.ws = (unsigned char*)d_ws; a.ph_lo = 0; a.ph_hi = 6;
    void* kargs[] = {&a};
    hipError_t e = hipLaunchCooperativeKernel((const void*)hybrid_fwd, dim3(grid), dim3(NWAVES * 64), kargs, LDS_BYTES, stream);
    if (e != hipSuccess) fprintf(stderr, "kernel_launch: cooperative launch failed: %s (grid %d)\n", hipGetErrorString(e), grid);
}
```
